# Optimizing an MI355X kernel written in HIP

```python
import math
import jax, jax.numpy as jnp
from jax import lax
import numpy as np

D_MODEL = 1024
BATCH = 16
SEQ = 2048
DEPTH = 2

HEAD_DIM = 64
N_HEADS_DIFF = 4
N_HEADS_FOX = 4
N_HEADS_MOBA = 4
N_BRANCH = 3
DIFF_QK_WIDTH = N_HEADS_DIFF * 2 * HEAD_DIM
DIFF_V_WIDTH = N_HEADS_DIFF * 2 * HEAD_DIM
FOX_WIDTH = N_HEADS_FOX * HEAD_DIM
MOBA_WIDTH = N_HEADS_MOBA * HEAD_DIM
D_IN = 2 * DIFF_QK_WIDTH + DIFF_V_WIDTH + 3 * FOX_WIDTH + 3 * MOBA_WIDTH + N_BRANCH * D_MODEL + N_HEADS_FOX
D_FF = ((8 * D_MODEL + 3 * 256 - 1) // (3 * 256)) * 256
ROPE_THETA = 10000.0
Q_BLOCK = 128
MOBA_BLOCK = 256
MOBA_TOPK = 3
MOBA_Q_CHUNK = 32
RMS_EPS = 1e-6
NEG_INF = -1e30

kernel_name = 'hybrid_diff_fox_moba_block'


def rmsnorm(x, g):
    xf = x.astype(jnp.float32)
    y = xf * lax.rsqrt(jnp.mean(xf * xf, axis=-1, keepdims=True) + RMS_EPS)
    return (y * g.astype(jnp.float32)).astype(x.dtype)


def rope_tables(positions):
    inv_freq = 1.0 / (ROPE_THETA ** (jnp.arange(0, HEAD_DIM, 2, dtype=jnp.float32) / HEAD_DIM))
    ang = positions.astype(jnp.float32)[..., None] * inv_freq
    return jnp.cos(ang)[:, :, None, :], jnp.sin(ang)[:, :, None, :]


def apply_rope(x, cos, sin):
    xf = x.astype(jnp.float32)
    x1, x2 = jnp.split(xf, 2, axis=-1)
    out = jnp.concatenate([x1 * cos - x2 * sin, x2 * cos + x1 * sin], axis=-1)
    return out.astype(x.dtype)


def causal_mask(q_start, n_q, n_k):
    qpos = q_start + jnp.arange(n_q)
    return jnp.arange(n_k)[None, :] <= qpos[:, None]


def diff_attention(q, k, v, lam, lam_init, g_subln):
    B, H, _, S, dh = q.shape
    kf = k.astype(jnp.float32)
    scale = dh ** -0.5

    def one_block(i):
        start = i * Q_BLOCK
        qb = lax.dynamic_slice_in_dim(q, start, Q_BLOCK, axis=3).astype(jnp.float32)
        logits = jnp.einsum('bhmqd,bhmkd->bhmqk', qb, kf) * scale
        logits = jnp.where(causal_mask(start, Q_BLOCK, S), logits, NEG_INF)
        p = jax.nn.softmax(logits, axis=-1)
        w = p[:, :, 0] - lam * p[:, :, 1]
        return jnp.einsum('bhqk,bhkd->bhqd', w.astype(v.dtype), v)

    o = lax.map(one_block, jnp.arange(S // Q_BLOCK))
    o = o.transpose(1, 2, 0, 3, 4).reshape(B, H, S, v.shape[-1])
    return rmsnorm(o, g_subln) * (1.0 - lam_init)


def forgetting_attention(q, k, v, log_f):
    B, H, S, dh = q.shape
    kf = k.astype(jnp.float32)
    cum = jnp.cumsum(log_f, axis=-1)
    scale = dh ** -0.5

    def one_block(i):
        start = i * Q_BLOCK
        qb = lax.dynamic_slice_in_dim(q, start, Q_BLOCK, axis=2).astype(jnp.float32)
        cq = lax.dynamic_slice_in_dim(cum, start, Q_BLOCK, axis=2)
        logits = jnp.einsum('bhqd,bhkd->bhqk', qb, kf) * scale
        logits = logits + cq[..., None] - cum[:, :, None, :]
        logits = jnp.where(causal_mask(start, Q_BLOCK, S), logits, NEG_INF)
        p = jax.nn.softmax(logits, axis=-1)
        return jnp.einsum('bhqk,bhkd->bhqd', p.astype(v.dtype), v)

    o = lax.map(one_block, jnp.arange(S // Q_BLOCK))
    return o.transpose(1, 2, 0, 3, 4).reshape(B, H, S, dh)


def moba_attention(q, k, v):
    B, H, S, dh = q.shape
    nb = -(-S // MOBA_BLOCK)
    pad = nb * MOBA_BLOCK - S
    kb = jnp.pad(k, ((0, 0), (0, 0), (0, pad), (0, 0))).reshape(B, H, nb, MOBA_BLOCK, dh)
    vb = jnp.pad(v, ((0, 0), (0, 0), (0, pad), (0, 0))).reshape(B, H, nb, MOBA_BLOCK, dh)
    kmean = jnp.mean(kb.astype(jnp.float32), axis=3)
    ksel = min(MOBA_TOPK, nb - 1)
    scale = dh ** -0.5
    b_idx = jnp.arange(B)[:, None, None, None]
    h_idx = jnp.arange(H)[None, :, None, None]

    def one_chunk(i):
        start = i * MOBA_Q_CHUNK
        qf = lax.dynamic_slice_in_dim(q, start, MOBA_Q_CHUNK, axis=2).astype(jnp.float32)
        qpos = start + jnp.arange(MOBA_Q_CHUNK)
        own = start // MOBA_BLOCK
        k_own = lax.dynamic_index_in_dim(kb, own, axis=2, keepdims=False)
        v_own = lax.dynamic_index_in_dim(vb, own, axis=2, keepdims=False)
        kpos_own = own * MOBA_BLOCK + jnp.arange(MOBA_BLOCK)
        lo = jnp.einsum('bhqd,bhkd->bhqk', qf, k_own.astype(jnp.float32)) * scale
        lo = jnp.where(kpos_own[None, :] <= qpos[:, None], lo, NEG_INF)
        if ksel == 0:
            p = jax.nn.softmax(lo, axis=-1)
            return jnp.einsum('bhqk,bhkd->bhqd', p.astype(v.dtype), v_own)
        gate = jnp.einsum('bhqd,bhnd->bhqn', qf, kmean)
        gate = jnp.where(jnp.arange(nb) < own, gate, NEG_INF)
        _, top_i = lax.top_k(gate, ksel)
        valid = top_i < own
        kg = kb[b_idx, h_idx, top_i]
        vg = vb[b_idx, h_idx, top_i]
        ls = jnp.einsum('bhqd,bhqnkd->bhqnk', qf, kg.astype(jnp.float32)) * scale
        ls = jnp.where(valid[..., None], ls, NEG_INF).reshape(B, H, MOBA_Q_CHUNK, ksel * MOBA_BLOCK)
        p = jax.nn.softmax(jnp.concatenate([ls, lo], axis=-1), axis=-1)
        ps = p[..., :ksel * MOBA_BLOCK].reshape(B, H, MOBA_Q_CHUNK, ksel, MOBA_BLOCK)
        po = p[..., ksel * MOBA_BLOCK:]
        return (jnp.einsum('bhqnk,bhqnkd->bhqd', ps.astype(v.dtype), vg)
                + jnp.einsum('bhqk,bhkd->bhqd', po.astype(v.dtype), v_own))

    o = lax.map(one_chunk, jnp.arange(S // MOBA_Q_CHUNK))
    return o.transpose(1, 2, 0, 3, 4).reshape(B, H, S, dh)


def hybrid_mixer(h, cos, sin, w_in, b_fgt, lam_q1, lam_k1, lam_q2, lam_k2, g_subln,
                 w_br_a, w_br_b, w_br_c, w_out, lam_init):
    B, S, _ = h.shape
    proj = jnp.einsum('bsd,de->bse', h, w_in)
    sizes = [DIFF_QK_WIDTH, DIFF_QK_WIDTH, DIFF_V_WIDTH,
             FOX_WIDTH, FOX_WIDTH, FOX_WIDTH,
             MOBA_WIDTH, MOBA_WIDTH, MOBA_WIDTH,
             N_BRANCH * D_MODEL, N_HEADS_FOX]
    idx = np.cumsum(sizes)[:-1].tolist()
    qa, ka, va, qb, kb, vb, qc, kc, vc, gate_logits, fgt_logits = jnp.split(proj, idx, axis=-1)

    def diff_qk(t):
        t = apply_rope(t.reshape(B, S, 2 * N_HEADS_DIFF, HEAD_DIM), cos, sin)
        return t.reshape(B, S, N_HEADS_DIFF, 2, HEAD_DIM).transpose(0, 2, 3, 1, 4)
    lam = (jnp.exp(jnp.sum(lam_q1.astype(jnp.float32) * lam_k1.astype(jnp.float32)))
           - jnp.exp(jnp.sum(lam_q2.astype(jnp.float32) * lam_k2.astype(jnp.float32))) + lam_init)
    va_h = va.reshape(B, S, N_HEADS_DIFF, 2 * HEAD_DIM).transpose(0, 2, 1, 3)
    oa = diff_attention(diff_qk(qa), diff_qk(ka), va_h, lam, lam_init, g_subln)
    ya = jnp.einsum('bse,ed->bsd', oa.transpose(0, 2, 1, 3).reshape(B, S, DIFF_V_WIDTH), w_br_a)

    def heads(t, n):
        return t.reshape(B, S, n, HEAD_DIM).transpose(0, 2, 1, 3)
    log_f = jax.nn.log_sigmoid(fgt_logits.astype(jnp.float32) + b_fgt.astype(jnp.float32))
    ob = forgetting_attention(heads(qb, N_HEADS_FOX), heads(kb, N_HEADS_FOX),
                              heads(vb, N_HEADS_FOX), log_f.transpose(0, 2, 1))
    yb = jnp.einsum('bse,ed->bsd', ob.transpose(0, 2, 1, 3).reshape(B, S, FOX_WIDTH), w_br_b)

    qc_r = apply_rope(qc.reshape(B, S, N_HEADS_MOBA, HEAD_DIM), cos, sin).transpose(0, 2, 1, 3)
    kc_r = apply_rope(kc.reshape(B, S, N_HEADS_MOBA, HEAD_DIM), cos, sin).transpose(0, 2, 1, 3)
    oc = moba_attention(qc_r, kc_r, heads(vc, N_HEADS_MOBA))
    yc = jnp.einsum('bse,ed->bsd', oc.transpose(0, 2, 1, 3).reshape(B, S, MOBA_WIDTH), w_br_c)

    g = jax.nn.sigmoid(gate_logits.astype(jnp.float32)).astype(h.dtype).reshape(B, S, N_BRANCH, D_MODEL)
    merged = g[:, :, 0] * ya + g[:, :, 1] * yb + g[:, :, 2] * yc
    return jnp.einsum('bsd,de->bse', merged, w_out)


def swiglu(h, w_gate_up, w_down):
    u = jnp.einsum('bsd,df->bsf', h, w_gate_up)
    a, b = jnp.split(u, 2, axis=-1)
    return jnp.einsum('bsf,fd->bsd', jax.nn.silu(a) * b, w_down)


def setup_inputs(seed: int = 0) -> dict:
    key = jax.random.key(seed)
    ks = jax.random.split(key, 24)

    def nrm(k, shape, scale):
        return jax.random.normal(k, shape, jnp.float32) * scale

    def gain(k, n):
        return 1.0 + nrm(k, (DEPTH, n), 0.05)

    return {
        'x': nrm(ks[0], (BATCH, SEQ, D_MODEL), 1.0),
        'c': nrm(ks[1], (BATCH, D_MODEL), 1.0),
        'positions': jnp.broadcast_to(jnp.arange(SEQ, dtype=jnp.int32)[None, :], (BATCH, SEQ)),
        'w_ada': nrm(ks[2], (DEPTH, D_MODEL, 6 * D_MODEL), 0.5 * D_MODEL ** -0.5),
        'b_ada': nrm(ks[3], (DEPTH, 6 * D_MODEL), 0.02),
        'g_pre_mix': gain(ks[4], D_MODEL),
        'g_post_mix': gain(ks[5], D_MODEL),
        'w_in': nrm(ks[6], (DEPTH, D_MODEL, D_IN), D_MODEL ** -0.5),
        'b_fgt': nrm(ks[7], (DEPTH, N_HEADS_FOX), 0.1),
        'lam_q1': nrm(ks[8], (DEPTH, HEAD_DIM), 0.1),
        'lam_k1': nrm(ks[9], (DEPTH, HEAD_DIM), 0.1),
        'lam_q2': nrm(ks[10], (DEPTH, HEAD_DIM), 0.1),
        'lam_k2': nrm(ks[11], (DEPTH, HEAD_DIM), 0.1),
        'g_subln': gain(ks[12], 2 * HEAD_DIM),
        'w_br_a': nrm(ks[13], (DEPTH, DIFF_V_WIDTH, D_MODEL), DIFF_V_WIDTH ** -0.5),
        'w_br_b': nrm(ks[14], (DEPTH, FOX_WIDTH, D_MODEL), FOX_WIDTH ** -0.5),
        'w_br_c': nrm(ks[15], (DEPTH, MOBA_WIDTH, D_MODEL), MOBA_WIDTH ** -0.5),
        'w_out': nrm(ks[16], (DEPTH, D_MODEL, D_MODEL), D_MODEL ** -0.5),
        'g_pre_ffn': gain(ks[17], D_MODEL),
        'g_post_ffn': gain(ks[18], D_MODEL),
        'w_gate_up': nrm(ks[19], (DEPTH, D_MODEL, 2 * D_FF), D_MODEL ** -0.5),
        'w_down': nrm(ks[20], (DEPTH, D_FF, D_MODEL), D_FF ** -0.5),
    }


def reference(x, c, positions, w_ada, b_ada, g_pre_mix, g_post_mix, w_in, b_fgt,
              lam_q1, lam_k1, lam_q2, lam_k2, g_subln, w_br_a, w_br_b, w_br_c, w_out,
              g_pre_ffn, g_post_ffn, w_gate_up, w_down):
    cos, sin = rope_tables(positions)
    c_act = jax.nn.silu(c)
    for l in range(DEPTH):
        lam_init = 0.8 - 0.6 * math.exp(-0.3 * l)
        mod = jnp.einsum('bd,de->be', c_act, w_ada[l]) + b_ada[l]
        sh_m, sc_m, gt_m, sh_f, sc_f, gt_f = [m[:, None, :] for m in jnp.split(mod, 6, axis=-1)]

        h = rmsnorm(x, g_pre_mix[l]) * (1.0 + sc_m) + sh_m
        y = hybrid_mixer(h, cos, sin, w_in[l], b_fgt[l], lam_q1[l], lam_k1[l], lam_q2[l], lam_k2[l],
                         g_subln[l], w_br_a[l], w_br_b[l], w_br_c[l], w_out[l], lam_init)
        x = x + gt_m * rmsnorm(y, g_post_mix[l])

        h = rmsnorm(x, g_pre_ffn[l]) * (1.0 + sc_f) + sh_f
        x = x + gt_f * rmsnorm(swiglu(h, w_gate_up[l], w_down[l]), g_post_ffn[l])
    return x
```

```cpp
#include <hip/hip_runtime.h>
#include <hip/hip_cooperative_groups.h>
#include <cstdio>
#include <cstdint>
namespace cg = cooperative_groups;
namespace pg8 {
#define PG8_LAS __attribute__((address_space(3)))
typedef unsigned short bf16_t;
typedef short bf16x8 __attribute__((ext_vector_type(8)));
typedef float f32x4 __attribute__((ext_vector_type(4)));
typedef unsigned u32x4 __attribute__((ext_vector_type(4)));
constexpr int BM = 256, BK = 64, HALF = 128, HTB = HALF * BK * 2  , STAGE_BYTES = 8 * HTB, NXCD = 8, WGM = 8;

__host__ __device__ __forceinline__ int lds_byte(int r, int c) { const int st = (r >> 4) * 2 + (c >> 5), rr = r & 15, cc = c & 31, ob = rr * 64 + cc * 2; return st * 1024 + (ob ^ (((ob >> 9) & 1) << 5)); }
__host__ __device__ __forceinline__ void stage_rc(int b, int& R, int& C) { const int st = b / 1024, sb = b % 1024, swz = sb ^ (((sb >> 9) & 1) << 5); R = (st >> 1) * 16 + swz / 64; C = (st & 1) * 32 + (swz % 64) / 2; }
__host__ __device__ __forceinline__ int perm32(int rho) { const int n = rho >> 4, i = rho & 15; return 8 * (i >> 2) + 4 * n + (i & 3); }

struct Unit { int pm, pn; };
struct Gemm { const bf16_t* A; const bf16_t* Bt; int M, N, K; };

struct StaticOrder {
    int nM, nN, nwg, G, c;
    __host__ __device__ void init(int M, int N, int G_, int c_) { nM = M / BM; nN = N / BM; nwg = nM * nN; G = G_; c = c_; }
    __host__ __device__ bool next(int i, Unit& u) const {
        const long L = (long)i * G + c; if (L >= nwg) return false;
        int wgid = (int)L; { const int q = nwg / NXCD, r = nwg % NXCD, xcd = wgid % NXCD, off = wgid / NXCD; wgid = (xcd < r ? xcd * (q + 1) : r * (q + 1) + (xcd - r) * q) + off; }
        const int nig = WGM * nN, gid = wgid / nig, fm = gid * WGM, gsz = (nM - fm) < WGM ? (nM - fm) : WGM;
        u.pm = fm + ((wgid % nig) % gsz); u.pn = (wgid % nig) / gsz; return true;
    }
    __device__ __forceinline__ void a_ready(const Unit&) const {}
    __device__ __forceinline__ void done(const Unit&) const {}
};

__device__ __forceinline__ unsigned cvt_pk_bf16(float lo, float hi) { unsigned r; asm volatile("v_cvt_pk_bf16_f32 %0, %1, %2" : "=v"(r) : "v"(lo), "v"(hi)); return r; }
template <class Epi, class Sched, bool ALIGN_EPI = false, bool SP2 = false>
__device__ __forceinline__ void gemm_phase(PG8_LAS unsigned char* lds, const Gemm g, const Sched& S, const Epi& E, const int tid_in) {
    int tid_ = tid_in; asm volatile("" : "+v"(tid_));
    const int tid = tid_, wid = __builtin_amdgcn_readfirstlane(tid >> 6), lane = tid & 63, wr = wid >> 2, wc = wid & 3, fr = lane & 15, fq = lane >> 4;
    const int K = g.K, nt = K / BK;
    unsigned voffA[2], voffB[2];
#pragma unroll
    for (int i = 0; i < 2; ++i) { int R, C; stage_rc(tid * 16 + i * 8192, R, C); const int Rb = Epi::PERM ? ((R & ~31) + perm32(R & 31)) : R;
        voffA[i] = (unsigned)(R * K + C) * 2u; voffB[i] = (unsigned)(Rb * K + C) * 2u; }
    const size_t kstep = (size_t)(BK * 2);
    const size_t hstep = (size_t)HALF * K * 2;
    const size_t tstep = 2 * hstep;
    const unsigned ldsw = (unsigned)wid * 1024u;
    const int aoff = lds_byte(wr * 64 + fr, fq * 8), boff = lds_byte(wc * 32 + fr, fq * 8);
#define PG8_SA(b, h) (((b) * 2 + (h)) * HTB)
#define PG8_SB(b, h) ((4 + (b) * 2 + (h)) * HTB)
#define PG8_STAGE(bufoff, gbase, voff) do { _Pragma("unroll") for (int _i = 0; _i < 2; ++_i) \
        __builtin_amdgcn_global_load_lds((const unsigned*)((const char*)(gbase) + (voff)[_i]), (PG8_LAS unsigned*)(lds + (bufoff) + ldsw + _i * 8192), 16, 0, 0); } while (0)
#define PG8_LDA(dst, b, h) do { _Pragma("unroll") for (int m = 0; m < 4; ++m) _Pragma("unroll") for (int k = 0; k < 2; ++k) dst[m][k] = *(const PG8_LAS bf16x8*)(lds + PG8_SA(b, h) + aoff + m * 2048 + k * 1024); } while (0)
#define PG8_LDB(dst, b, h) do { _Pragma("unroll") for (int n = 0; n < 2; ++n) _Pragma("unroll") for (int k = 0; k < 2; ++k) dst[n][k] = *(const PG8_LAS bf16x8*)(lds + PG8_SB(b, h) + boff + n * 2048 + k * 1024); } while (0)
#define PG8_MMA(ai, bj, At, Bt) do { __builtin_amdgcn_s_setprio(1); _Pragma("unroll") for (int m = 0; m < 4; ++m) _Pragma("unroll") for (int n = 0; n < 2; ++n) _Pragma("unroll") for (int k = 0; k < 2; ++k) \
        acc[ai][bj][m][n] = __builtin_amdgcn_mfma_f32_16x16x32_bf16(Bt[n][k], At[m][k], acc[ai][bj][m][n], 0, 0, 0); __builtin_amdgcn_s_setprio(0); } while (0)
#define PG8_WAIT_V(n) asm volatile("s_waitcnt vmcnt(" #n ")" ::: "memory")
#define PG8_WAIT_L(n) asm volatile("s_waitcnt lgkmcnt(" #n ")" ::: "memory")
#define PG8_BAR __builtin_amdgcn_s_barrier()
#define PG8_SCHED __builtin_amdgcn_sched_barrier(0)
    Unit cur, nxt; int ui = 0;
    if (!S.next(0, cur)) return;
    f32x4 acc[2][2][4][2];
#pragma unroll
    for (int a = 0; a < 2; ++a)
#pragma unroll
        for (int b = 0; b < 2; ++b)
#pragma unroll
            for (int m = 0; m < 4; ++m)
#pragma unroll
                for (int n = 0; n < 2; ++n) acc[a][b][m][n] = (f32x4){0.f, 0.f, 0.f, 0.f};
    bf16x8 At[4][2], B0[2][2], B1[2][2];
    const char* cA = (const char*)g.A + (size_t)cur.pm * tstep; const char* cB = (const char*)g.Bt + (size_t)cur.pn * tstep;
    S.a_ready(cur);
    if constexpr (SP2) {
        PG8_STAGE(PG8_SB(0, 0), cB, voffB); PG8_STAGE(PG8_SB(0, 1), cB + hstep, voffB); PG8_STAGE(PG8_SA(0, 0), cA, voffA); PG8_STAGE(PG8_SA(0, 1), cA + hstep, voffA);
        if (wr == 1) PG8_BAR;
        PG8_WAIT_V(2); PG8_BAR;
        PG8_STAGE(PG8_SB(1, 0), cB + kstep, voffB); PG8_STAGE(PG8_SA(1, 0), cA + kstep, voffA); PG8_STAGE(PG8_SB(1, 1), cB + hstep + kstep, voffB);
        PG8_WAIT_V(6); PG8_BAR;
    } else {
        PG8_STAGE(PG8_SB(0, 0), cB, voffB); PG8_STAGE(PG8_SA(0, 0), cA, voffA); PG8_STAGE(PG8_SB(0, 1), cB + hstep, voffB); PG8_STAGE(PG8_SA(0, 1), cA + hstep, voffA);
        if (wr == 1) PG8_BAR;
        PG8_WAIT_V(4); PG8_BAR;
        PG8_STAGE(PG8_SB(1, 0), cB + kstep, voffB); PG8_STAGE(PG8_SA(1, 0), cA + kstep, voffA); PG8_STAGE(PG8_SB(1, 1), cB + hstep + kstep, voffB);
        PG8_WAIT_V(6); PG8_BAR;
    }
    for (;;) {
        const bool has_next = S.next(ui + 1, nxt);
        const char* nA = has_next ? (const char*)g.A + (size_t)nxt.pm * tstep : cA; const char* nB = has_next ? (const char*)g.Bt + (size_t)nxt.pn * tstep : cB;
        for (int t = 0; t < nt; t += 2) {
            const bool last = (t == nt - 2);
            const char* a1 = cA + (size_t)(t + 1) * kstep;
            const char* a2 = last ? nA : cA + (size_t)(t + 2) * kstep; const char* b2 = last ? nB : cB + (size_t)(t + 2) * kstep;
            const char* a3 = a2 + kstep; const char* b3 = b2 + kstep;
            if (last && has_next) S.a_ready(nxt);
            if constexpr (SP2) {
            PG8_LDB(B0, 0, 0); PG8_LDB(B1, 0, 1); PG8_SCHED; PG8_LDA(At, 0, 0); PG8_STAGE(PG8_SA(1, 1), a1 + hstep, voffA);
            PG8_WAIT_V(8); PG8_WAIT_L(0); PG8_BAR; PG8_MMA(0, 0, At, B0); PG8_MMA(0, 1, At, B1); PG8_BAR; PG8_SCHED;
            PG8_LDA(At, 0, 1); PG8_STAGE(PG8_SB(0, 0), b2, voffB); PG8_STAGE(PG8_SB(0, 1), b2 + hstep, voffB); PG8_STAGE(PG8_SA(0, 0), a2, voffA);
            PG8_WAIT_V(8); PG8_WAIT_L(0); PG8_BAR; PG8_MMA(1, 0, At, B0); PG8_MMA(1, 1, At, B1); PG8_BAR; PG8_SCHED;
            PG8_LDB(B0, 1, 0); PG8_LDB(B1, 1, 1); PG8_SCHED; PG8_LDA(At, 1, 0); PG8_STAGE(PG8_SA(0, 1), a2 + hstep, voffA);
            PG8_WAIT_V(8); PG8_WAIT_L(0); PG8_BAR; PG8_MMA(0, 0, At, B0); PG8_MMA(0, 1, At, B1); PG8_BAR; PG8_SCHED;
            PG8_LDA(At, 1, 1); PG8_STAGE(PG8_SB(1, 0), b3, voffB); PG8_STAGE(PG8_SB(1, 1), b3 + hstep, voffB); PG8_STAGE(PG8_SA(1, 0), a3, voffA);
            PG8_WAIT_V(8); PG8_WAIT_L(0); PG8_BAR; PG8_MMA(1, 0, At, B0); PG8_MMA(1, 1, At, B1); PG8_BAR; PG8_SCHED;
            } else {
            PG8_LDB(B0, 0, 0); PG8_SCHED; PG8_LDA(At, 0, 0); PG8_STAGE(PG8_SA(1, 1), a1 + hstep, voffA);
            PG8_WAIT_L(8); PG8_BAR; PG8_WAIT_L(0); PG8_MMA(0, 0, At, B0); PG8_BAR; PG8_SCHED;
            PG8_LDB(B1, 0, 1); PG8_STAGE(PG8_SB(0, 0), b2, voffB);
            PG8_BAR; PG8_WAIT_L(0); PG8_MMA(0, 1, At, B1); PG8_BAR;
            PG8_LDA(At, 0, 1); PG8_STAGE(PG8_SA(0, 0), a2, voffA);
            PG8_BAR; PG8_WAIT_L(0); PG8_MMA(1, 0, At, B0); PG8_BAR; PG8_SCHED;
            PG8_STAGE(PG8_SB(0, 1), b2 + hstep, voffB);
            PG8_WAIT_V(6); PG8_BAR; PG8_MMA(1, 1, At, B1); PG8_BAR;
            PG8_LDB(B0, 1, 0); PG8_SCHED; PG8_LDA(At, 1, 0); PG8_STAGE(PG8_SA(0, 1), a2 + hstep, voffA);
            PG8_WAIT_L(8); PG8_BAR; PG8_WAIT_L(0); PG8_MMA(0, 0, At, B0); PG8_BAR; PG8_SCHED;
            PG8_LDB(B1, 1, 1); PG8_STAGE(PG8_SB(1, 0), b3, voffB);
            PG8_BAR; PG8_WAIT_L(0); PG8_MMA(0, 1, At, B1); PG8_BAR;
            PG8_LDA(At, 1, 1); PG8_STAGE(PG8_SA(1, 0), a3, voffA);
            PG8_BAR; PG8_WAIT_L(0); PG8_MMA(1, 0, At, B0); PG8_BAR; PG8_SCHED;
            PG8_STAGE(PG8_SB(1, 1), b3 + hstep, voffB);
            PG8_WAIT_V(6); PG8_BAR; PG8_MMA(1, 1, At, B1); PG8_BAR;
            }
        }
        if constexpr (ALIGN_EPI) { if (wr == 0) PG8_BAR; }
        if constexpr (!Epi::AFTER_DRAIN) { E(acc, cur, wr, wc, fr, fq); S.done(cur); }
        if (!has_next) break;
#pragma unroll
        for (int a = 0; a < 2; ++a)
#pragma unroll
            for (int b = 0; b < 2; ++b)
#pragma unroll
                for (int m = 0; m < 4; ++m)
#pragma unroll
                    for (int n = 0; n < 2; ++n) acc[a][b][m][n] = (f32x4){0.f, 0.f, 0.f, 0.f};
        cur = nxt; cA = nA; cB = nB; ++ui;
        if constexpr (ALIGN_EPI) { if (wr == 1) PG8_BAR; }
    }
    PG8_WAIT_V(0);
    if constexpr (!ALIGN_EPI) { if (wr == 0) PG8_BAR; }
    PG8_BAR;
    if constexpr (Epi::AFTER_DRAIN) { E.fused(acc, cur, wr, wc, fr, fq, lds, wid, lane); S.done(cur); }
#undef PG8_SA
#undef PG8_SB
#undef PG8_STAGE
#undef PG8_LDA
#undef PG8_LDB
#undef PG8_MMA
#undef PG8_WAIT_V
#undef PG8_WAIT_L
#undef PG8_BAR
#undef PG8_SCHED
}
}
using pg8::bf16_t; using pg8::bf16x8; using pg8::f32x4; using pg8::u32x4;
#define DI __device__ __forceinline__
#define LAS __attribute__((address_space(3)))
typedef float f32x16 __attribute__((ext_vector_type(16)));
typedef float f32x2 __attribute__((ext_vector_type(2)));
typedef unsigned u32x2 __attribute__((ext_vector_type(2)));
typedef __bf16 bf16v2 __attribute__((ext_vector_type(2)));

constexpr int NB = 16, SEQ = 2048, DM = 1024, MT = NB * SEQ, DIN = 6148, NQG = 6144, DFF = 2816, NGU = 5632;
constexpr float RMS_EPS = 1e-6f, LOG2E = 1.4426950408889634f;
constexpr size_t MiB = 1u << 20;
constexpr size_t WS_CTL = 0, WS_MOD = 1 * MiB, WS_LOGF = 2 * MiB, WS_CUM = 2 * MiB + 512 * 1024, WS_KMEAN = 3 * MiB;
constexpr size_t WS_WIN = 4 * MiB, WS_WBA = 16 * MiB, WS_WBB = 17 * MiB, WS_WBC = 17 * MiB + 512 * 1024, WS_WOUT = 18 * MiB, WS_WGU = 20 * MiB, WS_WDN = 31 * MiB;
constexpr size_t WS_H = 40 * MiB, WS_OA = WS_H, WS_OB = WS_H + 32 * MiB, WS_OC = WS_H + 48 * MiB;
constexpr size_t WS_QKV = 104 * MiB, WS_M32 = WS_QKV, WS_MERGED = WS_QKV + 128 * MiB, WS_Y = WS_QKV, WS_DN = WS_QKV + 64 * MiB;
constexpr size_t WS_GATE = 296 * MiB, WS_ACT = WS_GATE, WS_END = 488 * MiB;
constexpr size_t EL = 524288;
constexpr size_t QA_OFF = 0, KA_OFF = 32 * EL, VA_OFF = 64 * EL, QB_OFF = 96 * EL, KB_OFF = 112 * EL, VB_OFF = 128 * EL, QC_OFF = 144 * EL, KC_OFF = 160 * EL, VC_OFF = 176 * EL;
constexpr int LDS_BYTES = 147456, LDS_MISC = 131072;

DI unsigned pk2(float a, float b) { f32x2 v = {a, b}; bf16v2 r = __builtin_convertvector(v, bf16v2); return __builtin_bit_cast(unsigned, r); }
DI float bflo(unsigned w) { return __uint_as_float(w << 16); }
DI float bfhi(unsigned w) { return __uint_as_float(w & 0xffff0000u); }
DI float shx(float v, int mask, int lane) { return __int_as_float(__builtin_amdgcn_ds_bpermute((lane ^ mask) << 2, __float_as_int(v))); }
DI float wave_sum(float v, int lane) {
#pragma unroll
    for (int o = 1; o < 64; o <<= 1) v += shx(v, o, lane);
    return v;
}
DI int opaque_tid(int wave_s) { int t; asm volatile("v_mbcnt_lo_u32_b32 %0, -1, 0\n\tv_mbcnt_hi_u32_b32 %0, -1, %0" : "=v"(t)); return wave_s * 64 + t; }
#define LDS_WAIT() asm volatile("s_waitcnt lgkmcnt(0)" ::: "memory")

struct Params { const void* in[22]; float* out; unsigned char* ws; };

DI void phase_mod(const float* c, const float* w_ada, const float* b_ada, float* mod, unsigned char* lds, int wave_s) {
    float* cact = (float*)lds;
    float* red = (float*)(lds + 65536);
    const int tid = opaque_tid(wave_s);
    for (int i = tid; i < NB * DM; i += 512) { const float v = c[i]; cact[i] = v / (1.f + __expf(-v)); }
    __syncthreads();
    for (int it = blockIdx.x; it < 384; it += gridDim.x) {
        const int l = it / 192, e0 = (it % 192) * 32, col = tid & 31, kg = tid >> 5;
        const float* w = w_ada + (size_t)l * DM * 6144 + e0 + col;
        float acc[16];
#pragma unroll
        for (int b = 0; b < 16; ++b) acc[b] = 0.f;
#pragma unroll 4
        for (int kk = 0; kk < 64; ++kk) { const int k = kg * 64 + kk; const float wv = w[(size_t)k * 6144];
#pragma unroll
            for (int b = 0; b < 16; ++b) acc[b] += cact[b * DM + k] * wv; }
#pragma unroll
        for (int b = 0; b < 16; ++b) red[(kg * 16 + b) * 32 + col] = acc[b];
        __syncthreads();
        { const int b = tid >> 5; float s = b_ada[l * 6144 + e0 + col];
#pragma unroll
          for (int g = 0; g < 16; ++g) s += red[(g * 16 + b) * 32 + col];
          mod[(size_t)(l * 16 + b) * 6144 + e0 + col] = s; }
        __syncthreads();
    }
}

DI int sigma_col(int mode, int n) {
    if (mode == 1) { const int t = n >> 8; if (t <= 3 || t == 9 || t == 10) { const int c = n & 63; return (n & ~63) + 32 * ((c >> 2) & 1) + 4 * (c >> 3) + (c & 3); } return n; }
    if (mode == 2) { return ((n >> 2) & 1) * DFF + 4 * (n >> 3) + (n & 3); }
    return n;
}
DI void transpose_item(const float* W, int ld, int K, bf16_t* WT, int mode, float* scr, int item, int nblk, int lane) {
    const int kb = item / nblk, nb = item % nblk, k0 = 64 * kb, n0 = 32 * nb;
    const int src = sigma_col(mode, n0 + (lane & 31));
#pragma unroll 8
    for (int i = 0; i < 32; ++i) { const int kk = 2 * i + (lane >> 5); scr[kk * 33 + (lane & 31)] = W[(size_t)(k0 + kk) * ld + src]; }
    LDS_WAIT(); asm volatile("" ::: "memory");
    const int c = lane & 7;
#pragma unroll
    for (int j = 0; j < 4; ++j) { const int n = (lane >> 3) + 8 * j; const float* s = scr + (8 * c) * 33 + n;
        u32x4 o; o.x = pk2(s[0 * 33], s[1 * 33]); o.y = pk2(s[2 * 33], s[3 * 33]); o.z = pk2(s[4 * 33], s[5 * 33]); o.w = pk2(s[6 * 33], s[7 * 33]);
        *(u32x4*)(WT + (size_t)(n0 + n) * K + k0 + 8 * c) = o; }
    LDS_WAIT(); asm volatile("" ::: "memory");
}
template <class PP> DI void phase_conv(PP p, int l, unsigned char* lds, int wave_s) {
    const int tid = opaque_tid(wave_s), lane = tid & 63, wave = tid >> 6;
    float* scr = (float*)(lds + wave * 16384);
    const int gw = blockIdx.x * 8 + wave, NGW = gridDim.x * 8;
    unsigned char* ws = p->ws;
    const float* w_in = (const float*)p->in[7] + (size_t)l * DM * DIN;
    const float* w_a = (const float*)p->in[14] + (size_t)l * 512 * DM;
    const float* w_b = (const float*)p->in[15] + (size_t)l * 256 * DM;
    const float* w_c = (const float*)p->in[16] + (size_t)l * 256 * DM;
    const float* w_o = (const float*)p->in[17] + (size_t)l * DM * DM;
    const float* w_gu = (const float*)p->in[20] + (size_t)l * DM * NGU;
    const float* w_dn = (const float*)p->in[21] + (size_t)l * DFF * DM;
    constexpr int I1 = 16 * 192, I2 = 8 * 32, I3 = 4 * 32, I4 = 4 * 32, I5 = 16 * 32, I6 = 16 * 176, I7 = 44 * 32;
    constexpr int NIT = I1 + I2 + I3 + I4 + I5 + I6 + I7;
    for (int it = gw; it < NIT; it += NGW) {
        int r = it;
        if (r < I1) { transpose_item(w_in, DIN, DM, (bf16_t*)(ws + WS_WIN), 1, scr, r, 192, lane); continue; } r -= I1;
        if (r < I2) { transpose_item(w_a, DM, 512, (bf16_t*)(ws + WS_WBA), 0, scr, r, 32, lane); continue; } r -= I2;
        if (r < I3) { transpose_item(w_b, DM, 256, (bf16_t*)(ws + WS_WBB), 0, scr, r, 32, lane); continue; } r -= I3;
        if (r < I4) { transpose_item(w_c, DM, 256, (bf16_t*)(ws + WS_WBC), 0, scr, r, 32, lane); continue; } r -= I4;
        if (r < I5) { transpose_item(w_o, DM, DM, (bf16_t*)(ws + WS_WOUT), 0, scr, r, 32, lane); continue; } r -= I5;
        if (r < I6) { transpose_item(w_gu, NGU, DM, (bf16_t*)(ws + WS_WGU), 2, scr, r, 176, lane); continue; } r -= I6;
        transpose_item(w_dn, DM, DFF, (bf16_t*)(ws + WS_WDN), 0, scr, r, 32, lane);
    }
}

struct RowArgs {
    const float* xsrc; const bf16_t* y; const float* gpost; const float* gt;
    float* xdst;
    const float* gpre; const float* sc; const float* sh; bf16_t* hdst;
    const float* wfgt; const float* bfgt; float* logf;
};
DI void phase_rows(const RowArgs& a, unsigned char* lds, int wave_s) {
    const int tid = opaque_tid(wave_s), lane = tid & 63, wave = tid >> 6;
    float* wf = (float*)lds;
    if (a.wfgt) {
        for (int i = tid; i < DM * 4; i += 512) wf[i] = a.wfgt[(size_t)(i >> 2) * DIN + (i & 3)];
        __syncthreads();
    }
    const int gw = blockIdx.x * 8 + wave, NGW = gridDim.x * 8;
    for (int m = gw; m < MT; m += NGW) {
        const int b = m >> 11;
        f32x4 x[4];
#pragma unroll
        for (int j = 0; j < 4; ++j) x[j] = *(const f32x4*)(a.xsrc + (size_t)m * DM + 4 * lane + 256 * j);
        if (a.y) {
            f32x4 yv[4]; float ss = 0.f;
#pragma unroll
            for (int j = 0; j < 4; ++j) { const u32x2 w = *(const u32x2*)(a.y + (size_t)m * DM + 4 * lane + 256 * j);
                yv[j] = (f32x4){bflo(w.x), bfhi(w.x), bflo(w.y), bfhi(w.y)}; ss += (yv[j].x * yv[j].x + yv[j].y * yv[j].y) + (yv[j].z * yv[j].z + yv[j].w * yv[j].w); }
            const float rstd = rsqrtf(wave_sum(ss, lane) * (1.f / DM) + RMS_EPS);
#pragma unroll
            for (int j = 0; j < 4; ++j) { const int col = 4 * lane + 256 * j;
                const f32x4 g = *(const f32x4*)(a.gpost + col), t = *(const f32x4*)(a.gt + (size_t)b * 6144 + col);
                x[j] = x[j] + t * (yv[j] * rstd * g); }
        }
        if (a.xdst) {
#pragma unroll
            for (int j = 0; j < 4; ++j) *(f32x4*)(a.xdst + (size_t)m * DM + 4 * lane + 256 * j) = x[j];
        }
        if (a.hdst) {
            float ss = 0.f;
#pragma unroll
            for (int j = 0; j < 4; ++j) ss += (x[j].x * x[j].x + x[j].y * x[j].y) + (x[j].z * x[j].z + x[j].w * x[j].w);
            const float rstd = rsqrtf(wave_sum(ss, lane) * (1.f / DM) + RMS_EPS);
            float lg0 = 0.f, lg1 = 0.f, lg2 = 0.f, lg3 = 0.f;
#pragma unroll
            for (int j = 0; j < 4; ++j) { const int col = 4 * lane + 256 * j;
                const f32x4 g = *(const f32x4*)(a.gpre + col), s1 = *(const f32x4*)(a.sc + (size_t)b * 6144 + col), s0 = *(const f32x4*)(a.sh + (size_t)b * 6144 + col);
                const f32x4 hv = x[j] * rstd * g * (s1 + 1.0f) + s0;
                u32x2 o; o.x = pk2(hv.x, hv.y); o.y = pk2(hv.z, hv.w);
                *(u32x2*)(a.hdst + (size_t)m * DM + col) = o;
                if (a.wfgt) {
#pragma unroll
                    for (int e = 0; e < 4; ++e) { const f32x4 w4 = *(const f32x4*)(wf + (col + e) * 4); const float hh = hv[e];
                        lg0 += hh * w4.x; lg1 += hh * w4.y; lg2 += hh * w4.z; lg3 += hh * w4.w; }
                }
            }
            if (a.wfgt) {
                lg0 = wave_sum(lg0, lane); lg1 = wave_sum(lg1, lane); lg2 = wave_sum(lg2, lane); lg3 = wave_sum(lg3, lane);
                if (lane < 4) { const float z = (lane == 0 ? lg0 : lane == 1 ? lg1 : lane == 2 ? lg2 : lg3) + a.bfgt[lane];
                    const float lf = fminf(z, 0.f) - __logf(1.f + __expf(-fabsf(z)));
                    a.logf[(size_t)(b * 4 + lane) * SEQ + (m & (SEQ - 1))] = lf; }
            }
        }
    }
}
struct EpiIn {
    static constexpr bool PERM = true, AFTER_DRAIN = false;
    bf16_t* qkv; bf16_t* gate; const int* pos;
    DI void operator()(const f32x4 (&acc)[2][2][4][2], const pg8::Unit& u, int wr, int wc, int fr, int fq) const {
        const int pn = u.pn, row0 = u.pm * 256 + wr * 64 + fr;
        if (pn >= 12) {
            const int col0 = (pn - 12) * 256 + wc * 32 + 8 * fq;
#pragma unroll
            for (int ai = 0; ai < 2; ++ai)
#pragma unroll
                for (int m = 0; m < 4; ++m) { bf16_t* rowp = gate + (size_t)(row0 + ai * 128 + m * 16) * 3072 + col0;
#pragma unroll
                    for (int bj = 0; bj < 2; ++bj) { const f32x4 v0 = acc[ai][bj][m][0], v1 = acc[ai][bj][m][1]; float s[8];
#pragma unroll
                        for (int e = 0; e < 4; ++e) { s[e] = 1.f / (1.f + __expf(-v0[e])); s[4 + e] = 1.f / (1.f + __expf(-v1[e])); }
                        u32x4 w; w.x = pk2(s[0], s[1]); w.y = pk2(s[2], s[3]); w.z = pk2(s[4], s[5]); w.w = pk2(s[6], s[7]);
                        *(u32x4*)(rowp + bj * 128) = w; } }
        } else if (pn == 4 || pn == 5 || pn == 8 || pn == 11) {
            const bool wide = (pn <= 5);
            const size_t toff = wide ? VA_OFF : (pn == 8 ? VB_OFF : VC_OFF);
            const int DV = wide ? 128 : 64;
            const int b = u.pm >> 3, sbase = (u.pm & 7) * 256 + wr * 64;
            const int hh = (fr >> 2) & 1, j = ((fr >> 3) << 2) | (fr & 3);
#pragma unroll
            for (int bj = 0; bj < 2; ++bj) {
                const int head = wide ? (2 * (pn - 4) + bj) : (2 * bj + (wc >> 1));
                const int dbase = wide ? (32 * wc + 8 * fq) : (32 * (wc & 1) + 8 * fq);
                const int bh = b * 4 + head;
#pragma unroll
                for (int ai = 0; ai < 2; ++ai)
#pragma unroll
                    for (int m = 0; m < 4; ++m) { const int s = sbase + ai * 128 + m * 16, tile = s >> 5, st = m & 1;
                        bf16_t* bp = qkv + toff + ((size_t)(((bh * 64 + tile) * 2 + st) * 2 + hh) * DV + dbase) * 8 + j;
#pragma unroll
                        for (int n = 0; n < 2; ++n) { const f32x4 v = acc[ai][bj][m][n];
                            const unsigned w0 = pk2(v[0], v[1]), w1 = pk2(v[2], v[3]);
                            bp[(4 * n + 0) * 8] = (bf16_t)(w0 & 0xffffu); bp[(4 * n + 1) * 8] = (bf16_t)(w0 >> 16);
                            bp[(4 * n + 2) * 8] = (bf16_t)(w1 & 0xffffu); bp[(4 * n + 3) * 8] = (bf16_t)(w1 >> 16); } }
            }
        } else {
            const bool rope = !(pn == 6 || pn == 7);
            size_t toff; int NH, hbase;
            if (pn <= 1) { toff = QA_OFF; NH = 8; hbase = 4 * (pn & 1); }
            else if (pn <= 3) { toff = KA_OFF; NH = 8; hbase = 4 * (pn & 1); }
            else if (pn == 6) { toff = QB_OFF; NH = 4; hbase = 0; }
            else if (pn == 7) { toff = KB_OFF; NH = 4; hbase = 0; }
            else if (pn == 9) { toff = QC_OFF; NH = 4; hbase = 0; }
            else { toff = KC_OFF; NH = 4; hbase = 0; }
            const int b = u.pm >> 3, sbase = (u.pm & 7) * 256 + wr * 64 + fr;
            const int c0 = 32 * (wc & 1) + 8 * fq;
            float invf[4];
#pragma unroll
            for (int e = 0; e < 4; ++e) invf[e] = __builtin_amdgcn_exp2f(-(float)(16 * (wc & 1) + 4 * fq + e) * (13.287712379549449f / 32.0f));
#pragma unroll
            for (int ai = 0; ai < 2; ++ai)
#pragma unroll
                for (int m = 0; m < 4; ++m) { const int s = sbase + ai * 128 + m * 16;
                    float cs[4], sn[4];
                    if (rope) { const float pf = (float)pos[b * SEQ + s];
#pragma unroll
                        for (int e = 0; e < 4; ++e) { float t = (pf * invf[e]) * 0.15915494309189535f; t = t - floorf(t); sn[e] = __builtin_amdgcn_sinf(t); cs[e] = __builtin_amdgcn_cosf(t); } }
                    else {
#pragma unroll
                        for (int e = 0; e < 4; ++e) { cs[e] = 1.f; sn[e] = 0.f; } }
#pragma unroll
                    for (int bj = 0; bj < 2; ++bj) { const int head = hbase + 2 * bj + (wc >> 1);
                        const f32x4 x1 = acc[ai][bj][m][0], x2 = acc[ai][bj][m][1]; float o1[4], o2[4];
#pragma unroll
                        for (int e = 0; e < 4; ++e) { o1[e] = x1[e] * cs[e] - x2[e] * sn[e]; o2[e] = x2[e] * cs[e] + x1[e] * sn[e]; }
                        u32x4 w; w.x = pk2(o1[0], o1[1]); w.y = pk2(o1[2], o1[3]); w.z = pk2(o2[0], o2[1]); w.w = pk2(o2[2], o2[3]);
                        *(u32x4*)(qkv + toff + ((size_t)((b * NH + head) * SEQ + s)) * 64 + c0) = w; } }
        }
    }
};
template <int PASS> struct EpiMerge {
    static constexpr bool PERM = true, AFTER_DRAIN = false;
    const bf16_t* gate; float* m32; bf16_t* merged;
    DI void operator()(const f32x4 (&acc)[2][2][4][2], const pg8::Unit& u, int wr, int wc, int fr, int fq) const {
        const int row0 = u.pm * 256 + wr * 64 + fr, col0 = u.pn * 256 + wc * 32 + 8 * fq;
#pragma unroll
        for (int ai = 0; ai < 2; ++ai)
#pragma unroll
            for (int m = 0; m < 4; ++m) { const size_t row = (size_t)(row0 + ai * 128 + m * 16);
#pragma unroll
                for (int bj = 0; bj < 2; ++bj) { const int col = col0 + bj * 128;
                    const u32x4 g = *(const u32x4*)(gate + row * 3072 + PASS * 1024 + col);
                    f32x4 v0 = acc[ai][bj][m][0] * (f32x4){bflo(g.x), bfhi(g.x), bflo(g.y), bfhi(g.y)};
                    f32x4 v1 = acc[ai][bj][m][1] * (f32x4){bflo(g.z), bfhi(g.z), bflo(g.w), bfhi(g.w)};
                    float* mp = m32 + row * DM + col;
                    if (PASS > 0) { v0 = v0 + *(const f32x4*)mp; v1 = v1 + *(const f32x4*)(mp + 4); }
                    if (PASS < 2) { *(f32x4*)mp = v0; *(f32x4*)(mp + 4) = v1; }
                    else { u32x4 w; w.x = pk2(v0[0], v0[1]); w.y = pk2(v0[2], v0[3]); w.z = pk2(v1[0], v1[1]); w.w = pk2(v1[2], v1[3]);
                        *(u32x4*)(merged + row * DM + col) = w; } } }
    }
};
struct EpiPlain {
    static constexpr bool PERM = true, AFTER_DRAIN = false;
    bf16_t* O; int ldc;
    DI void operator()(const f32x4 (&acc)[2][2][4][2], const pg8::Unit& u, int wr, int wc, int fr, int fq) const {
        const int row0 = u.pm * 256 + wr * 64 + fr, col0 = u.pn * 256 + wc * 32 + 8 * fq;
#pragma unroll
        for (int ai = 0; ai < 2; ++ai)
#pragma unroll
            for (int m = 0; m < 4; ++m) { bf16_t* rowp = O + (size_t)(row0 + ai * 128 + m * 16) * ldc + col0;
#pragma unroll
                for (int bj = 0; bj < 2; ++bj) { const f32x4 v0 = acc[ai][bj][m][0], v1 = acc[ai][bj][m][1];
                    u32x4 w; w.x = pk2(v0[0], v0[1]); w.y = pk2(v0[2], v0[3]); w.z = pk2(v1[0], v1[1]); w.w = pk2(v1[2], v1[3]);
                    *(u32x4*)(rowp + bj * 128) = w; } }
    }
};
struct EpiSwiglu {
    static constexpr bool PERM = true, AFTER_DRAIN = false;
    bf16_t* act;
    DI void operator()(const f32x4 (&acc)[2][2][4][2], const pg8::Unit& u, int wr, int wc, int fr, int fq) const {
        const int row0 = u.pm * 256 + wr * 64 + fr, col0 = u.pn * 128 + wc * 16 + 4 * fq;
#pragma unroll
        for (int ai = 0; ai < 2; ++ai)
#pragma unroll
            for (int m = 0; m < 4; ++m) { bf16_t* rowp = act + (size_t)(row0 + ai * 128 + m * 16) * DFF + col0;
#pragma unroll
                for (int bj = 0; bj < 2; ++bj) { const f32x4 a = acc[ai][bj][m][0], bv = acc[ai][bj][m][1]; float r[4];
#pragma unroll
                    for (int e = 0; e < 4; ++e) r[e] = a[e] / (1.f + __expf(-a[e])) * bv[e];
                    u32x2 w; w.x = pk2(r[0], r[1]); w.y = pk2(r[2], r[3]);
                    *(u32x2*)(rowp + bj * 64) = w; } }
    }
};

DI void phase_mini(const float* logf, float* cum, const bf16_t* kc, float* kmean, unsigned* ctl, int wave_s) {
    const int tid = opaque_tid(wave_s), lane = tid & 63, wave = tid >> 6;
    if (blockIdx.x == 0 && tid == 0) ctl[0] = 0u;
    const int gw = blockIdx.x * 8 + wave, NGW = gridDim.x * 8;
    for (int it = gw; it < 64 + 512; it += NGW) {
        if (it < 64) {
            const float* src = logf + (size_t)it * SEQ + lane * 32; float* dst = cum + (size_t)it * SEQ + lane * 32;
            f32x4 v[8]; float run = 0.f;
#pragma unroll
            for (int j = 0; j < 8; ++j) { v[j] = *(const f32x4*)(src + 4 * j); v[j].x += run; v[j].y += v[j].x; v[j].z += v[j].y; v[j].w += v[j].z; run = v[j].w; }
            float incl = run;
#pragma unroll
            for (int o = 1; o < 64; o <<= 1) { const int srcl = lane >= o ? lane - o : lane; const float t = __int_as_float(__builtin_amdgcn_ds_bpermute(srcl << 2, __float_as_int(incl))); if (lane >= o) incl += t; }
            const float excl = incl - run;
#pragma unroll
            for (int j = 0; j < 8; ++j) *(f32x4*)(dst + 4 * j) = v[j] + excl;
        } else {
            const int idx = it - 64, bh = idx >> 3, n = idx & 7;
            const bf16_t* kp = kc + ((size_t)bh * SEQ + n * 256) * 64 + 2 * (lane & 31);
            float a0 = 0.f, a1 = 0.f;
#pragma unroll 8
            for (int i = 0; i < 128; ++i) { const unsigned w = *(const unsigned*)(kp + (size_t)((lane >> 5) + 2 * i) * 64); a0 += bflo(w); a1 += bfhi(w); }
            a0 += shx(a0, 32, lane); a1 += shx(a1, 32, lane);
            if (lane < 32) { kmean[(size_t)idx * 64 + 2 * lane] = a0 * (1.f / 256.f); kmean[(size_t)idx * 64 + 2 * lane + 1] = a1 * (1.f / 256.f); }
        }
    }
}

#define MFMA32(a, b, c) __builtin_amdgcn_mfma_f32_32x32x16_bf16((a), (b), (c), 0, 0, 0)
template <int DT, int MODE>
DI void attn_stream(const bf16_t* __restrict__ Qh, const bf16_t* __restrict__ Kh, const bf16_t* __restrict__ Vt, const int q0, const int lane,
                    f32x16 (&O)[DT], float& l_out, const float* __restrict__ cum, const float* __restrict__ kmean) {
    constexpr int DV = DT * 32;
    const int r = lane & 31, h = lane >> 5;
    const float SCL = 0.125f * LOG2E;
    bf16x8 qf[4];
#pragma unroll
    for (int c = 0; c < 4; ++c) qf[c] = *(const bf16x8*)(Qh + (size_t)(q0 + r) * 64 + h * 32 + c * 8);
    const int last = q0 >> 5, own = q0 >> 8;
    unsigned sel = 0u, anysel = 0u;
    if (MODE == 2) {
        if (own <= 3) sel = (1u << own) - 1u;
        else {
            float g[7];
#pragma unroll
            for (int n = 0; n < 7; ++n) {
                float part = 0.f;
                if (n < own) {
#pragma unroll
                    for (int c = 0; c < 4; ++c) { const float* kmp = kmean + n * 64 + h * 32 + c * 8; const f32x4 k0 = *(const f32x4*)kmp, k1 = *(const f32x4*)(kmp + 4);
                        const u32x4 qw = __builtin_bit_cast(u32x4, qf[c]);
                        part += bflo(qw.x) * k0.x + bfhi(qw.x) * k0.y + bflo(qw.y) * k0.z + bfhi(qw.y) * k0.w + bflo(qw.z) * k1.x + bfhi(qw.z) * k1.y + bflo(qw.w) * k1.z + bfhi(qw.w) * k1.w; }
                    part += shx(part, 32, lane);
                } else part = -3.0e38f;
                g[n] = part;
            }
#pragma unroll
            for (int t = 0; t < 3; ++t) { float bv = -3.4e38f; int best = 0;
#pragma unroll
                for (int n = 0; n < 7; ++n) { const bool ok = (n < own) && !((sel >> n) & 1u) && (g[n] > bv); bv = ok ? g[n] : bv; best = ok ? n : best; }
                sel |= 1u << best; }
        }
        const unsigned long long b0 = __ballot((sel >> 0) & 1u), b1 = __ballot((sel >> 1) & 1u), b2 = __ballot((sel >> 2) & 1u), b3 = __ballot((sel >> 3) & 1u),
                                 b4 = __ballot((sel >> 4) & 1u), b5 = __ballot((sel >> 5) & 1u), b6 = __ballot((sel >> 6) & 1u);
        anysel = (b0 ? 1u : 0u) | (b1 ? 2u : 0u) | (b2 ? 4u : 0u) | (b3 ? 8u : 0u) | (b4 ? 16u : 0u) | (b5 ? 32u : 0u) | (b6 ? 64u : 0u);
    }
    float cql = 0.f;
    if (MODE == 1) cql = cum[q0 + r] * LOG2E;
    float m_run = -1.0e30f, l_run = 0.f;
#pragma unroll
    for (int dt = 0; dt < DT; ++dt)
#pragma unroll
        for (int i = 0; i < 16; ++i) O[dt][i] = 0.f;

    auto nxt = [&](int kt) -> int {
        int k = kt + 1;
        if (MODE == 2) { while (k < own * 8 && !((anysel >> (k >> 3)) & 1u)) k = ((k >> 3) + 1) * 8; }
        return k;
    };
    bf16x8 kf[4];
    int kt = nxt(-1);
#pragma unroll
    for (int c = 0; c < 4; ++c) kf[c] = *(const bf16x8*)(Kh + (size_t)(kt * 32 + r) * 64 + h * 32 + c * 8);
    while (kt <= last) {
        bf16x8 vf[2][DT];
#pragma unroll
        for (int st = 0; st < 2; ++st)
#pragma unroll
            for (int dt = 0; dt < DT; ++dt) vf[st][dt] = *(const bf16x8*)(Vt + ((size_t)(((kt * 2 + st) * 2 + h) * DV) + dt * 32 + r) * 8);
        f32x16 S;
#pragma unroll
        for (int i = 0; i < 16; ++i) S[i] = 0.f;
#pragma unroll
        for (int c = 0; c < 4; ++c) S = MFMA32(kf[c], qf[c], S);
        const int k2 = nxt(kt);
        { const int kk = k2 < last ? k2 : last;
#pragma unroll
          for (int c = 0; c < 4; ++c) kf[c] = *(const bf16x8*)(Kh + (size_t)(kk * 32 + r) * 64 + h * 32 + c * 8); }
        float t[16];
#pragma unroll
        for (int i = 0; i < 16; ++i) t[i] = S[i] * SCL;
        if (MODE == 1) {
#pragma unroll
            for (int g = 0; g < 4; ++g) { const f32x4 ck = *(const f32x4*)(cum + kt * 32 + 8 * g + 4 * h);
#pragma unroll
                for (int e = 0; e < 4; ++e) t[4 * g + e] += cql - ck[e] * LOG2E; }
        }
        const bool diag = (kt == last);
        bool rowsel = true;
        if (MODE == 2) { const int n = kt >> 3; if (n < own) rowsel = ((sel >> n) & 1u) != 0u; }
        if (diag || MODE == 2) {
#pragma unroll
            for (int i = 0; i < 16; ++i) { const int kr = (i & 3) + 8 * (i >> 2) + 4 * h; const bool valid = rowsel && (!diag || kr <= r); t[i] = valid ? t[i] : -1.0e30f; }
        }
        float mx = t[0];
#pragma unroll
        for (int i = 1; i < 16; ++i) mx = fmaxf(mx, t[i]);
        mx = fmaxf(mx, shx(mx, 32, lane));
        const float m_new = fmaxf(m_run, mx);
        const float alpha = __builtin_amdgcn_exp2f(m_run - m_new);
        float p[16]; float ls = 0.f;
#pragma unroll
        for (int i = 0; i < 16; ++i) { const float e = __builtin_amdgcn_exp2f(t[i] - m_new); p[i] = (t[i] <= -1.0e29f) ? 0.f : e; ls += p[i]; }
        l_run = l_run * alpha + ls; m_run = m_new;
#pragma unroll
        for (int dt = 0; dt < DT; ++dt)
#pragma unroll
            for (int i = 0; i < 16; ++i) O[dt][i] *= alpha;
#pragma unroll
        for (int st = 0; st < 2; ++st) {
            u32x4 pw; pw.x = pk2(p[8 * st + 0], p[8 * st + 1]); pw.y = pk2(p[8 * st + 2], p[8 * st + 3]); pw.z = pk2(p[8 * st + 4], p[8 * st + 5]); pw.w = pk2(p[8 * st + 6], p[8 * st + 7]);
            const bf16x8 pf = __builtin_bit_cast(bf16x8, pw);
#pragma unroll
            for (int dt = 0; dt < DT; ++dt) O[dt] = MFMA32(vf[st][dt], pf, O[dt]);
        }
        kt = k2;
    }
    l_out = l_run + shx(l_run, 32, lane);
}

struct AttnArgs { const bf16_t* qkv; bf16_t* oa; bf16_t* ob; bf16_t* oc; const float* cum; const float* kmean; const float* gsub; float lam, lam_init; unsigned* ctl; };
DI void phase_attn(const AttnArgs& a, unsigned char* lds, int wave_s) {
    const int tid = opaque_tid(wave_s), lane0 = tid & 63, wave = tid >> 6;
    volatile unsigned* bc = (volatile unsigned*)(lds + LDS_MISC);
    float* stash = (float*)(lds + wave * 16384);
    for (;;) {
        if (tid == 0) bc[0] = atomicAdd(a.ctl, 1u);
        __syncthreads();
        const unsigned u = bc[0];
        __syncthreads();
        if (u >= 1536u) break;
        int lane = lane0; asm volatile("" : "+v"(lane));
        const int r = lane & 31, h = lane >> 5;
        if (u < 512u) {
            const int qb = 7 - (int)(u >> 6), bh = (int)(u & 63u), b = bh >> 2, head = bh & 3;
            const int q0 = qb * 256 + wave * 32;
            const bf16_t* Vt = a.qkv + VA_OFF + (size_t)bh * SEQ * 128;
#pragma unroll 1
            for (int half = 0; half < 2; ++half) {
                f32x16 O[4]; float l;
                attn_stream<4, 0>(a.qkv + QA_OFF + (size_t)(b * 8 + 2 * head + half) * SEQ * 64, a.qkv + KA_OFF + (size_t)(b * 8 + 2 * head + half) * SEQ * 64, Vt, q0, lane, O, l, nullptr, nullptr);
                if (half == 0) {
                    const float inv = 1.f / l;
#pragma unroll
                    for (int dt = 0; dt < 4; ++dt) {
#pragma unroll
                        for (int i = 0; i < 16; ++i) stash[(dt * 16 + i) * 64 + lane] = O[dt][i] * inv;
                        asm volatile("" ::: "memory"); }
                } else {
                    const float inv = a.lam / l; float ss = 0.f;
#pragma unroll
                    for (int dt = 0; dt < 4; ++dt) {
#pragma unroll
                        for (int i = 0; i < 16; ++i) { const float o = stash[(dt * 16 + i) * 64 + lane] - O[dt][i] * inv; O[dt][i] = o; ss += o * o; }
                        asm volatile("" ::: "memory"); }
                    ss += shx(ss, 32, lane);
                    const float rstd = rsqrtf(ss * (1.f / 128.f) + RMS_EPS) * (1.f - a.lam_init);
                    bf16_t* op = a.oa + (size_t)(b * SEQ + q0 + r) * 512 + head * 128;
#pragma unroll
                    for (int dt = 0; dt < 4; ++dt) {
#pragma unroll
                        for (int g = 0; g < 4; ++g) { const int d = dt * 32 + 8 * g + 4 * h; const f32x4 gs = *(const f32x4*)(a.gsub + d);
                            u32x2 w; w.x = pk2(O[dt][4 * g] * rstd * gs.x, O[dt][4 * g + 1] * rstd * gs.y); w.y = pk2(O[dt][4 * g + 2] * rstd * gs.z, O[dt][4 * g + 3] * rstd * gs.w);
                            *(u32x2*)(op + d) = w; }
                        asm volatile("" ::: "memory"); }
                }
            }
        } else {
            const unsigned v = u - 512u; const int qb = 7 - (int)(v >> 7), w7 = (int)(v & 127u), typ = 1 + (w7 >> 6), bh = w7 & 63, b = bh >> 2, head = bh & 3;
            const int q0 = qb * 256 + wave * 32;
            f32x16 O[2]; float l;
            bf16_t* op;
            if (typ == 1) {
                attn_stream<2, 1>(a.qkv + QB_OFF + (size_t)bh * SEQ * 64, a.qkv + KB_OFF + (size_t)bh * SEQ * 64, a.qkv + VB_OFF + (size_t)bh * SEQ * 64, q0, lane, O, l, a.cum + (size_t)bh * SEQ, nullptr);
                op = a.ob + (size_t)(b * SEQ + q0 + r) * 256 + head * 64;
            } else {
                attn_stream<2, 2>(a.qkv + QC_OFF + (size_t)bh * SEQ * 64, a.qkv + KC_OFF + (size_t)bh * SEQ * 64, a.qkv + VC_OFF + (size_t)bh * SEQ * 64, q0, lane, O, l, nullptr, a.kmean + (size_t)bh * 8 * 64);
                op = a.oc + (size_t)(b * SEQ + q0 + r) * 256 + head * 64;
            }
            const float inv = 1.f / l;
#pragma unroll
            for (int dt = 0; dt < 2; ++dt)
#pragma unroll
                for (int g = 0; g < 4; ++g) { const int d = dt * 32 + 8 * g + 4 * h;
                    u32x2 w; w.x = pk2(O[dt][4 * g] * inv, O[dt][4 * g + 1] * inv); w.y = pk2(O[dt][4 * g + 2] * inv, O[dt][4 * g + 3] * inv);
                    *(u32x2*)(op + d) = w; }
        }
    }
}

typedef const Params __attribute__((address_space(4))) CParams;
DI CParams* fresh_params() { CParams* kp = (CParams*)__builtin_amdgcn_kernarg_segment_ptr(); asm volatile("" : "+s"(kp)); return kp; }
#define PHASE_BEGIN CParams* kp = fresh_params(); unsigned char* ws = kp->ws; (void)ws;
#define PIN(i) (kp->in[i])
#define MODP ((float*)(ws + WS_MOD))
__global__ void __launch_bounds__(512, 2) fwd_megakernel(Params p) {
    extern __shared__ __attribute__((aligned(16))) unsigned char lds[];
    cg::grid_group grid = cg::this_grid();
    const int wave_s = __builtin_amdgcn_readfirstlane((int)(threadIdx.x >> 6));
    {
        PHASE_BEGIN
#ifndef NO_P0
        phase_mod((const float*)PIN(1), (const float*)PIN(3), (const float*)PIN(4), MODP, lds, wave_s);
        __syncthreads();
        phase_conv(kp, 0, lds, wave_s);
#endif
    }
    grid.sync();
    {
        PHASE_BEGIN
        RowArgs a{};
        a.xsrc = (const float*)PIN(0); a.y = nullptr; a.gpost = nullptr; a.gt = nullptr; a.xdst = nullptr;
        a.gpre = (const float*)PIN(5); a.sc = MODP + 1 * DM; a.sh = MODP + 0 * DM; a.hdst = (bf16_t*)(ws + WS_H);
        a.wfgt = (const float*)PIN(7) + 6144; a.bfgt = (const float*)PIN(8); a.logf = (float*)(ws + WS_LOGF);
        phase_rows(a, lds, wave_s);
    }
    grid.sync();
#pragma unroll 1
    for (int l = 0; l < 2; ++l) {
        {
            PHASE_BEGIN
            pg8::Gemm g{(const bf16_t*)(ws + WS_H), (const bf16_t*)(ws + WS_WIN), MT, NQG, DM}; pg8::StaticOrder S; S.init(MT, NQG, (int)gridDim.x, (int)blockIdx.x);
            EpiIn E{(bf16_t*)(ws + WS_QKV), (bf16_t*)(ws + WS_GATE), (const int*)PIN(2)};
            pg8::gemm_phase<EpiIn, pg8::StaticOrder, true, true>((PG8_LAS unsigned char*)lds, g, S, E, opaque_tid(wave_s));
        }
        grid.sync();
        {
            PHASE_BEGIN
            phase_mini((const float*)(ws + WS_LOGF), (float*)(ws + WS_CUM), (const bf16_t*)(ws + WS_QKV) + KC_OFF, (float*)(ws + WS_KMEAN), (unsigned*)(ws + WS_CTL), wave_s);
        }
        grid.sync();
        {
            PHASE_BEGIN
            const int lane = opaque_tid(wave_s) & 63;
            const float lam_init = (l == 0) ? 0.2f : 0.35550906759f;
            const float q1 = ((const float*)PIN(9))[l * 64 + lane], k1 = ((const float*)PIN(10))[l * 64 + lane];
            const float q2 = ((const float*)PIN(11))[l * 64 + lane], k2 = ((const float*)PIN(12))[l * 64 + lane];
            const float lam = __expf(wave_sum(q1 * k1, lane)) - __expf(wave_sum(q2 * k2, lane)) + lam_init;
            AttnArgs a{(const bf16_t*)(ws + WS_QKV), (bf16_t*)(ws + WS_OA), (bf16_t*)(ws + WS_OB), (bf16_t*)(ws + WS_OC), (const float*)(ws + WS_CUM), (const float*)(ws + WS_KMEAN),
                       (const float*)PIN(13) + l * 128, lam, lam_init, (unsigned*)(ws + WS_CTL)};
#ifndef NO_ATTN
            phase_attn(a, lds, wave_s);
#endif
        }
        grid.sync();
        {
            PHASE_BEGIN
            pg8::StaticOrder S; S.init(MT, DM, (int)gridDim.x, (int)blockIdx.x);
            pg8::Gemm g{(const bf16_t*)(ws + WS_OA), (const bf16_t*)(ws + WS_WBA), MT, DM, 512}; EpiMerge<0> E{(const bf16_t*)(ws + WS_GATE), (float*)(ws + WS_M32), (bf16_t*)(ws + WS_MERGED)};
            pg8::gemm_phase<EpiMerge<0>, pg8::StaticOrder, true, true>((PG8_LAS unsigned char*)lds, g, S, E, opaque_tid(wave_s));
        }
        {
            PHASE_BEGIN
            pg8::StaticOrder S; S.init(MT, DM, (int)gridDim.x, (int)blockIdx.x);
            pg8::Gemm g{(const bf16_t*)(ws + WS_OB), (const bf16_t*)(ws + WS_WBB), MT, DM, 256}; EpiMerge<1> E{(const bf16_t*)(ws + WS_GATE), (float*)(ws + WS_M32), (bf16_t*)(ws + WS_MERGED)};
            pg8::gemm_phase<EpiMerge<1>, pg8::StaticOrder, true, true>((PG8_LAS unsigned char*)lds, g, S, E, opaque_tid(wave_s));
        }
        {
            PHASE_BEGIN
            pg8::StaticOrder S; S.init(MT, DM, (int)gridDim.x, (int)blockIdx.x);
            pg8::Gemm g{(const bf16_t*)(ws + WS_OC), (const bf16_t*)(ws + WS_WBC), MT, DM, 256}; EpiMerge<2> E{(const bf16_t*)(ws + WS_GATE), (float*)(ws + WS_M32), (bf16_t*)(ws + WS_MERGED)};
            pg8::gemm_phase<EpiMerge<2>, pg8::StaticOrder, true, true>((PG8_LAS unsigned char*)lds, g, S, E, opaque_tid(wave_s));
        }
        grid.sync();
        {
            PHASE_BEGIN
            pg8::Gemm g{(const bf16_t*)(ws + WS_MERGED), (const bf16_t*)(ws + WS_WOUT), MT, DM, DM}; pg8::StaticOrder S; S.init(MT, DM, (int)gridDim.x, (int)blockIdx.x);
            EpiPlain E{(bf16_t*)(ws + WS_Y), DM};
            pg8::gemm_phase<EpiPlain, pg8::StaticOrder, true, true>((PG8_LAS unsigned char*)lds, g, S, E, opaque_tid(wave_s));
        }
        grid.sync();
        {
            PHASE_BEGIN
            const float* modl = MODP + (size_t)l * 16 * 6144;
            RowArgs a{};
            a.xsrc = (l == 0) ? (const float*)PIN(0) : (const float*)kp->out; a.y = (const bf16_t*)(ws + WS_Y); a.gpost = (const float*)PIN(6) + l * DM; a.gt = modl + 2 * DM; a.xdst = kp->out;
            a.gpre = (const float*)PIN(18) + l * DM; a.sc = modl + 4 * DM; a.sh = modl + 3 * DM; a.hdst = (bf16_t*)(ws + WS_H);
            a.wfgt = nullptr; a.bfgt = nullptr; a.logf = nullptr;
            phase_rows(a, lds, wave_s);
        }
        grid.sync();
        {
            PHASE_BEGIN
            pg8::Gemm g{(const bf16_t*)(ws + WS_H), (const bf16_t*)(ws + WS_WGU), MT, NGU, DM}; pg8::StaticOrder S; S.init(MT, NGU, (int)gridDim.x, (int)blockIdx.x);
            EpiSwiglu E{(bf16_t*)(ws + WS_ACT)};
            pg8::gemm_phase<EpiSwiglu, pg8::StaticOrder, true, true>((PG8_LAS unsigned char*)lds, g, S, E, opaque_tid(wave_s));
        }
        grid.sync();
        {
            PHASE_BEGIN
            pg8::Gemm g{(const bf16_t*)(ws + WS_ACT), (const bf16_t*)(ws + WS_WDN), MT, DM, DFF}; pg8::StaticOrder S; S.init(MT, DM, (int)gridDim.x, (int)blockIdx.x);
            EpiPlain E{(bf16_t*)(ws + WS_DN), DM};
            pg8::gemm_phase<EpiPlain, pg8::StaticOrder, true, true>((PG8_LAS unsigned char*)lds, g, S, E, opaque_tid(wave_s));
        }
        grid.sync();
        {
            PHASE_BEGIN
            const float* modl = MODP + (size_t)l * 16 * 6144;
            RowArgs a{};
            a.xsrc = kp->out; a.y = (const bf16_t*)(ws + WS_DN); a.gpost = (const float*)PIN(19) + l * DM; a.gt = modl + 5 * DM; a.xdst = kp->out;
            if (l == 0) {
                const float* mod1 = MODP + (size_t)16 * 6144;
                a.gpre = (const float*)PIN(5) + DM; a.sc = mod1 + 1 * DM; a.sh = mod1 + 0 * DM; a.hdst = (bf16_t*)(ws + WS_H);
                a.wfgt = (const float*)PIN(7) + (size_t)DM * DIN + 6144; a.bfgt = (const float*)PIN(8) + 4; a.logf = (float*)(ws + WS_LOGF);
            } else { a.gpre = nullptr; a.sc = nullptr; a.sh = nullptr; a.hdst = nullptr; a.wfgt = nullptr; a.bfgt = nullptr; a.logf = nullptr; }
            phase_rows(a, lds, wave_s);
            if (l == 0) {
                __syncthreads();
#ifndef NO_P0
                phase_conv(kp, 1, lds, wave_s);
#endif
            }
        }
        if (l == 0) grid.sync();
    }
}

extern "C" void kernel_launch(void* const* d_in, const int* in_sizes, int n_in, void* d_out, int out_size, void* d_ws, size_t ws_size, hipStream_t stream) {
    static int grid = 0;
    if (grid == 0) {
        if (n_in != 22 || out_size != MT * DM || ws_size < WS_END) { fprintf(stderr, "kernel_launch: unexpected problem (n_in %d, out %d, ws %zu)\n", n_in, out_size, ws_size); grid = -1; return; }
        int dev = 0, cus = 0, per_cu = 0;
        if (hipGetDevice(&dev) != hipSuccess || hipDeviceGetAttribute(&cus, hipDeviceAttributeMultiprocessorCount, dev) != hipSuccess) { grid = -1; return; }
        if (hipFuncSetAttribute((const void*)fwd_megakernel, hipFuncAttributeMaxDynamicSharedMemorySize, LDS_BYTES) != hipSuccess) { fprintf(stderr, "kernel_launch: hipFuncSetAttribute failed\n"); grid = -1; return; }
        if (hipOccupancyMaxActiveBlocksPerMultiprocessor(&per_cu, (const void*)fwd_megakernel, 512, LDS_BYTES) != hipSuccess || per_cu < 1) { fprintf(stderr, "kernel_launch: occupancy query says %d\n", per_cu); per_cu = 1; }
        (void)hipGetLastError();
        grid = cus * 1;
    }
    if (grid < 0) return;
    Params p{};
    for (int i = 0; i < 22; ++i) p.in[i] = d_in[i];
    p.out = (float*)d_out; p.ws = (unsigned char*)d_ws;
    void* args[] = {&p};
    const hipError_t e = hipLaunchCooperativeKernel((const void*)fwd_megakernel, dim3(grid), dim3(512), args, LDS_BYTES, stream);
    if (e != hipSuccess) fprintf(stderr, "kernel_launch: cooperative launch failed: %s (grid %d)\n", hipGetErrorString(e), grid);
}
```

```cpp
#include <hip/hip_runtime.h>
#include <hip/hip_cooperative_groups.h>
#include <cstdio>
#include <cstdint>
#include <type_traits>
namespace cg = cooperative_groups;
namespace pg8 {
#define PG8_LAS __attribute__((address_space(3)))
typedef unsigned short bf16_t;
typedef short bf16x8 __attribute__((ext_vector_type(8)));
typedef float f32x4 __attribute__((ext_vector_type(4)));
typedef unsigned u32x4 __attribute__((ext_vector_type(4)));
constexpr int BM = 256, BK = 64, HALF = 128, HTB = HALF * BK * 2  , STAGE_BYTES = 8 * HTB, NXCD = 8, WGM = 8;

__host__ __device__ __forceinline__ int lds_byte(int r, int c) { const int st = (r >> 4) * 2 + (c >> 5), rr = r & 15, cc = c & 31, ob = rr * 64 + cc * 2; return st * 1024 + (ob ^ (((ob >> 9) & 1) << 5)); }
__host__ __device__ __forceinline__ void stage_rc(int b, int& R, int& C) { const int st = b / 1024, sb = b % 1024, swz = sb ^ (((sb >> 9) & 1) << 5); R = (st >> 1) * 16 + swz / 64; C = (st & 1) * 32 + (swz % 64) / 2; }
__host__ __device__ __forceinline__ int perm32(int rho) { const int n = rho >> 4, i = rho & 15; return 8 * (i >> 2) + 4 * n + (i & 3); }

struct Unit { int pm, pn; };
struct Gemm { const bf16_t* A; const bf16_t* Bt; int M, N, K; };

struct StaticOrder {
    int nM, nN, nwg, G, c;
    __host__ __device__ void init(int M, int N, int G_, int c_) { nM = M / BM; nN = N / BM; nwg = nM * nN; G = G_; c = c_; }
    __host__ __device__ bool next(int i, Unit& u) const {
        const long L = (long)i * G + c; if (L >= nwg) return false;
        int wgid = (int)L; { const int q = nwg / NXCD, r = nwg % NXCD, xcd = wgid % NXCD, off = wgid / NXCD; wgid = (xcd < r ? xcd * (q + 1) : r * (q + 1) + (xcd - r) * q) + off; }
        const int nig = WGM * nN, gid = wgid / nig, fm = gid * WGM, gsz = (nM - fm) < WGM ? (nM - fm) : WGM;
        u.pm = fm + ((wgid % nig) % gsz); u.pn = (wgid % nig) / gsz; return true;
    }
    __device__ __forceinline__ void a_ready(const Unit&) const {}
    __device__ __forceinline__ void done(const Unit&) const {}
};

__device__ __forceinline__ unsigned cvt_pk_bf16(float lo, float hi) { unsigned r; asm volatile("v_cvt_pk_bf16_f32 %0, %1, %2" : "=v"(r) : "v"(lo), "v"(hi)); return r; }
template <class Epi, class Sched, bool ALIGN_EPI = false, bool SP2 = false>
__device__ __forceinline__ void gemm_phase(PG8_LAS unsigned char* lds, const Gemm g, const Sched& S, const Epi& E, const int tid_in) {
    int tid_ = tid_in; asm volatile("" : "+v"(tid_));
    const int tid = tid_, wid = __builtin_amdgcn_readfirstlane(tid >> 6), lane = tid & 63, wr = wid >> 2, wc = wid & 3, fr = lane & 15, fq = lane >> 4;
    const int K = g.K, nt = K / BK;
    unsigned voffA[2], voffB[2];
#pragma unroll
    for (int i = 0; i < 2; ++i) { int R, C; stage_rc(tid * 16 + i * 8192, R, C); const int Rb = Epi::PERM ? ((R & ~31) + perm32(R & 31)) : R;
        voffA[i] = (unsigned)(R * K + C) * 2u; voffB[i] = (unsigned)(Rb * K + C) * 2u; }
    const size_t kstep = (size_t)(BK * 2);
    const size_t hstep = (size_t)HALF * K * 2;
    const size_t tstep = 2 * hstep;
    const unsigned ldsw = (unsigned)wid * 1024u;
    const int aoff = lds_byte(wr * 64 + fr, fq * 8), boff = lds_byte(wc * 32 + fr, fq * 8);
#define PG8_SA(b, h) (((b) * 2 + (h)) * HTB)
#define PG8_SB(b, h) ((4 + (b) * 2 + (h)) * HTB)
#define PG8_STAGE(bufoff, gbase, voff) do { _Pragma("unroll") for (int _i = 0; _i < 2; ++_i) \
        __builtin_amdgcn_global_load_lds((const unsigned*)((const char*)(gbase) + (voff)[_i]), (PG8_LAS unsigned*)(lds + (bufoff) + ldsw + _i * 8192), 16, 0, 0); } while (0)
#define PG8_LDA(dst, b, h) do { _Pragma("unroll") for (int m = 0; m < 4; ++m) _Pragma("unroll") for (int k = 0; k < 2; ++k) dst[m][k] = *(const PG8_LAS bf16x8*)(lds + PG8_SA(b, h) + aoff + m * 2048 + k * 1024); } while (0)
#define PG8_LDB(dst, b, h) do { _Pragma("unroll") for (int n = 0; n < 2; ++n) _Pragma("unroll") for (int k = 0; k < 2; ++k) dst[n][k] = *(const PG8_LAS bf16x8*)(lds + PG8_SB(b, h) + boff + n * 2048 + k * 1024); } while (0)
#define PG8_MMA(ai, bj, At, Bt) do { __builtin_amdgcn_s_setprio(1); _Pragma("unroll") for (int m = 0; m < 4; ++m) _Pragma("unroll") for (int n = 0; n < 2; ++n) _Pragma("unroll") for (int k = 0; k < 2; ++k) \
        acc[ai][bj][m][n] = __builtin_amdgcn_mfma_f32_16x16x32_bf16(Bt[n][k], At[m][k], acc[ai][bj][m][n], 0, 0, 0); __builtin_amdgcn_s_setprio(0); } while (0)
#define PG8_WAIT_V(n) asm volatile("s_waitcnt vmcnt(" #n ")" ::: "memory")
#define PG8_WAIT_L(n) asm volatile("s_waitcnt lgkmcnt(" #n ")" ::: "memory")
#define PG8_BAR __builtin_amdgcn_s_barrier()
#define PG8_SCHED __builtin_amdgcn_sched_barrier(0)
    Unit cur, nxt; int ui = 0;
    if (!S.next(0, cur)) return;
    f32x4 acc[2][2][4][2];
#pragma unroll
    for (int a = 0; a < 2; ++a)
#pragma unroll
        for (int b = 0; b < 2; ++b)
#pragma unroll
            for (int m = 0; m < 4; ++m)
#pragma unroll
                for (int n = 0; n < 2; ++n) acc[a][b][m][n] = (f32x4){0.f, 0.f, 0.f, 0.f};
    bf16x8 At[4][2], B0[2][2], B1[2][2];
    const char* cA = (const char*)g.A + (size_t)cur.pm * tstep; const char* cB = (const char*)g.Bt + (size_t)cur.pn * tstep;
    S.a_ready(cur);
    if constexpr (SP2) {
        PG8_STAGE(PG8_SB(0, 0), cB, voffB); PG8_STAGE(PG8_SB(0, 1), cB + hstep, voffB); PG8_STAGE(PG8_SA(0, 0), cA, voffA); PG8_STAGE(PG8_SA(0, 1), cA + hstep, voffA);
        if (wr == 1) PG8_BAR;
        PG8_WAIT_V(2); PG8_BAR;
        PG8_STAGE(PG8_SB(1, 0), cB + kstep, voffB); PG8_STAGE(PG8_SA(1, 0), cA + kstep, voffA); PG8_STAGE(PG8_SB(1, 1), cB + hstep + kstep, voffB);
        PG8_WAIT_V(6); PG8_BAR;
    } else {
        PG8_STAGE(PG8_SB(0, 0), cB, voffB); PG8_STAGE(PG8_SA(0, 0), cA, voffA); PG8_STAGE(PG8_SB(0, 1), cB + hstep, voffB); PG8_STAGE(PG8_SA(0, 1), cA + hstep, voffA);
        if (wr == 1) PG8_BAR;
        PG8_WAIT_V(4); PG8_BAR;
        PG8_STAGE(PG8_SB(1, 0), cB + kstep, voffB); PG8_STAGE(PG8_SA(1, 0), cA + kstep, voffA); PG8_STAGE(PG8_SB(1, 1), cB + hstep + kstep, voffB);
        PG8_WAIT_V(6); PG8_BAR;
    }
    for (;;) {
        const bool has_next = S.next(ui + 1, nxt);
        const char* nA = has_next ? (const char*)g.A + (size_t)nxt.pm * tstep : cA; const char* nB = has_next ? (const char*)g.Bt + (size_t)nxt.pn * tstep : cB;
        for (int t = 0; t < nt; t += 2) {
            if constexpr (Epi::KHOOK) E.khook(acc, cur, t, wr, wc, fr, fq);
            const bool last = (t == nt - 2);
            const char* a1 = cA + (size_t)(t + 1) * kstep;
            const char* a2 = last ? nA : cA + (size_t)(t + 2) * kstep; const char* b2 = last ? nB : cB + (size_t)(t + 2) * kstep;
            const char* a3 = a2 + kstep; const char* b3 = b2 + kstep;
            if (last && has_next) S.a_ready(nxt);
            if constexpr (SP2) {
            PG8_LDB(B0, 0, 0); PG8_LDB(B1, 0, 1); PG8_SCHED; PG8_LDA(At, 0, 0); PG8_STAGE(PG8_SA(1, 1), a1 + hstep, voffA);
            PG8_WAIT_V(8); PG8_WAIT_L(0); PG8_BAR; PG8_MMA(0, 0, At, B0); PG8_MMA(0, 1, At, B1); PG8_BAR; PG8_SCHED;
            PG8_LDA(At, 0, 1); PG8_STAGE(PG8_SB(0, 0), b2, voffB); PG8_STAGE(PG8_SB(0, 1), b2 + hstep, voffB); PG8_STAGE(PG8_SA(0, 0), a2, voffA);
            PG8_WAIT_V(8); PG8_WAIT_L(0); PG8_BAR; PG8_MMA(1, 0, At, B0); PG8_MMA(1, 1, At, B1); PG8_BAR; PG8_SCHED;
            PG8_LDB(B0, 1, 0); PG8_LDB(B1, 1, 1); PG8_SCHED; PG8_LDA(At, 1, 0); PG8_STAGE(PG8_SA(0, 1), a2 + hstep, voffA);
            PG8_WAIT_V(8); PG8_WAIT_L(0); PG8_BAR; PG8_MMA(0, 0, At, B0); PG8_MMA(0, 1, At, B1); PG8_BAR; PG8_SCHED;
            PG8_LDA(At, 1, 1); PG8_STAGE(PG8_SB(1, 0), b3, voffB); PG8_STAGE(PG8_SB(1, 1), b3 + hstep, voffB); PG8_STAGE(PG8_SA(1, 0), a3, voffA);
            PG8_WAIT_V(8); PG8_WAIT_L(0); PG8_BAR; PG8_MMA(1, 0, At, B0); PG8_MMA(1, 1, At, B1); PG8_BAR; PG8_SCHED;
            } else {
            PG8_LDB(B0, 0, 0); PG8_SCHED; PG8_LDA(At, 0, 0); PG8_STAGE(PG8_SA(1, 1), a1 + hstep, voffA);
            PG8_WAIT_L(8); PG8_BAR; PG8_WAIT_L(0); PG8_MMA(0, 0, At, B0); PG8_BAR; PG8_SCHED;
            PG8_LDB(B1, 0, 1); PG8_STAGE(PG8_SB(0, 0), b2, voffB);
            PG8_BAR; PG8_WAIT_L(0); PG8_MMA(0, 1, At, B1); PG8_BAR;
            PG8_LDA(At, 0, 1); PG8_STAGE(PG8_SA(0, 0), a2, voffA);
            PG8_BAR; PG8_WAIT_L(0); PG8_MMA(1, 0, At, B0); PG8_BAR; PG8_SCHED;
            PG8_STAGE(PG8_SB(0, 1), b2 + hstep, voffB);
            PG8_WAIT_V(6); PG8_BAR; PG8_MMA(1, 1, At, B1); PG8_BAR;
            PG8_LDB(B0, 1, 0); PG8_SCHED; PG8_LDA(At, 1, 0); PG8_STAGE(PG8_SA(0, 1), a2 + hstep, voffA);
            PG8_WAIT_L(8); PG8_BAR; PG8_WAIT_L(0); PG8_MMA(0, 0, At, B0); PG8_BAR; PG8_SCHED;
            PG8_LDB(B1, 1, 1); PG8_STAGE(PG8_SB(1, 0), b3, voffB);
            PG8_BAR; PG8_WAIT_L(0); PG8_MMA(0, 1, At, B1); PG8_BAR;
            PG8_LDA(At, 1, 1); PG8_STAGE(PG8_SA(1, 0), a3, voffA);
            PG8_BAR; PG8_WAIT_L(0); PG8_MMA(1, 0, At, B0); PG8_BAR; PG8_SCHED;
            PG8_STAGE(PG8_SB(1, 1), b3 + hstep, voffB);
            PG8_WAIT_V(6); PG8_BAR; PG8_MMA(1, 1, At, B1); PG8_BAR;
            }
        }
        if constexpr (ALIGN_EPI) { if (wr == 0) PG8_BAR; }
        if constexpr (!Epi::AFTER_DRAIN) { E(acc, cur, wr, wc, fr, fq); S.done(cur); }
        if (!has_next) break;
#pragma unroll
        for (int a = 0; a < 2; ++a)
#pragma unroll
            for (int b = 0; b < 2; ++b)
#pragma unroll
                for (int m = 0; m < 4; ++m)
#pragma unroll
                    for (int n = 0; n < 2; ++n) acc[a][b][m][n] = (f32x4){0.f, 0.f, 0.f, 0.f};
        cur = nxt; cA = nA; cB = nB; ++ui;
        if constexpr (ALIGN_EPI) { if (wr == 1) PG8_BAR; }
    }
    PG8_WAIT_V(0);
    if constexpr (!ALIGN_EPI) { if (wr == 0) PG8_BAR; }
    PG8_BAR;
    if constexpr (Epi::AFTER_DRAIN) { E.fused(acc, cur, wr, wc, fr, fq, lds, wid, lane); S.done(cur); }
#undef PG8_SA
#undef PG8_SB
#undef PG8_STAGE
#undef PG8_LDA
#undef PG8_LDB
#undef PG8_MMA
#undef PG8_WAIT_V
#undef PG8_WAIT_L
#undef PG8_BAR
#undef PG8_SCHED
}
}
using pg8::bf16_t; using pg8::bf16x8; using pg8::f32x4; using pg8::u32x4;
#define DI __device__ __forceinline__
#define LAS __attribute__((address_space(3)))
typedef float f32x16 __attribute__((ext_vector_type(16)));
typedef float f32x2 __attribute__((ext_vector_type(2)));
typedef unsigned u32x2 __attribute__((ext_vector_type(2)));
typedef __bf16 bf16v2 __attribute__((ext_vector_type(2)));

constexpr int NB = 16, SEQ = 2048, DM = 1024, MT = NB * SEQ, DIN = 6148, NQG = 6144, DFF = 2816, NGU = 5632;
constexpr float RMS_EPS = 1e-6f, LOG2E = 1.4426950408889634f;
constexpr size_t MiB = 1u << 20;
constexpr size_t WS_CTL = 0, WS_BAR = 16384, WS_MOD = 1 * MiB, WS_LOGF = 2 * MiB, WS_CUM = 2 * MiB + 512 * 1024, WS_KMEAN = 3 * MiB;
constexpr size_t WS_WIN = 4 * MiB, WS_WBA = 16 * MiB, WS_WBB = 17 * MiB, WS_WBC = 17 * MiB + 512 * 1024, WS_WOUT = 18 * MiB, WS_WGU = 20 * MiB, WS_WDN = 31 * MiB;
constexpr size_t WS_H = 40 * MiB, WS_OA = WS_H, WS_OB = WS_H + 32 * MiB, WS_OC = WS_H + 48 * MiB;
constexpr size_t WS_QKV = 104 * MiB, WS_M32 = WS_QKV, WS_MERGED = WS_QKV + 128 * MiB, WS_Y = WS_QKV, WS_DN = WS_QKV + 64 * MiB;
constexpr size_t WS_GATE = 296 * MiB, WS_ACT = WS_GATE, WS_END = 488 * MiB;
constexpr size_t EL = 524288;
constexpr size_t QA_OFF = 0, KA_OFF = 32 * EL, VA_OFF = 64 * EL, QB_OFF = 96 * EL, KB_OFF = 112 * EL, VB_OFF = 128 * EL, QC_OFF = 144 * EL, KC_OFF = 160 * EL, VC_OFF = 176 * EL;
constexpr int LDS_BYTES = 163840, LDS_MISC = 163840 - 512;

DI unsigned pk2(float a, float b) { f32x2 v = {a, b}; bf16v2 r = __builtin_convertvector(v, bf16v2); return __builtin_bit_cast(unsigned, r); }
DI float bflo(unsigned w) { return __uint_as_float(w << 16); }
DI float bfhi(unsigned w) { return __uint_as_float(w & 0xffff0000u); }
DI float shx(float v, int mask, int lane) { return __int_as_float(__builtin_amdgcn_ds_bpermute((lane ^ mask) << 2, __float_as_int(v))); }
DI float wave_sum(float v, int lane) {
#pragma unroll
    for (int o = 1; o < 64; o <<= 1) v += shx(v, o, lane);
    return v;
}
DI int opaque_tid(int wave_s) { int t; asm volatile("v_mbcnt_lo_u32_b32 %0, -1, 0\n\tv_mbcnt_hi_u32_b32 %0, -1, %0" : "=v"(t)); return wave_s * 64 + t; }
#define LDS_WAIT() asm volatile("s_waitcnt lgkmcnt(0)" ::: "memory")

struct Params { const void* in[22]; float* out; unsigned char* ws; };

DI void phase_mod(const float* c, const float* w_ada, const float* b_ada, float* mod, unsigned char* lds, int wave_s) {
    float* cact = (float*)lds;
    float* red = (float*)(lds + 65536);
    const int tid = opaque_tid(wave_s);
    for (int i = tid; i < NB * DM; i += 512) { const float v = c[i]; cact[i] = v / (1.f + __expf(-v)); }
    __syncthreads();
    for (int it = blockIdx.x; it < 384; it += gridDim.x) {
        const int l = it / 192, e0 = (it % 192) * 32, col = tid & 31, kg = tid >> 5;
        const float* w = w_ada + (size_t)l * DM * 6144 + e0 + col;
        float acc[16];
#pragma unroll
        for (int b = 0; b < 16; ++b) acc[b] = 0.f;
#pragma unroll 4
        for (int kk = 0; kk < 64; ++kk) { const int k = kg * 64 + kk; const float wv = w[(size_t)k * 6144];
#pragma unroll
            for (int b = 0; b < 16; ++b) acc[b] += cact[b * DM + k] * wv; }
#pragma unroll
        for (int b = 0; b < 16; ++b) red[(kg * 16 + b) * 32 + col] = acc[b];
        __syncthreads();
        { const int b = tid >> 5; float s = b_ada[l * 6144 + e0 + col];
#pragma unroll
          for (int g = 0; g < 16; ++g) s += red[(g * 16 + b) * 32 + col];
          mod[(size_t)(l * 16 + b) * 6144 + e0 + col] = s; }
        __syncthreads();
    }
}

DI int sigma_col(int mode, int n) {
    if (mode == 1) { const int t = n >> 8; if (t <= 3 || t == 9 || t == 10) { const int c = n & 63; return (n & ~63) + 32 * ((c >> 2) & 1) + 4 * (c >> 3) + (c & 3); } return n; }
    if (mode == 2) { return ((n >> 2) & 1) * DFF + 4 * (n >> 3) + (n & 3); }
    return n;
}
DI void transpose_item(const float* W, int ld, int K, bf16_t* WT, int mode, float* scr, int item, int nblk, int lane) {
    const int kb = item / nblk, nb = item % nblk, k0 = 64 * kb, n0 = 32 * nb;
    const int src = sigma_col(mode, n0 + (lane & 31));
#pragma unroll 8
    for (int i = 0; i < 32; ++i) { const int kk = 2 * i + (lane >> 5); scr[kk * 33 + (lane & 31)] = W[(size_t)(k0 + kk) * ld + src]; }
    LDS_WAIT(); asm volatile("" ::: "memory");
    const int c = lane & 7;
#pragma unroll
    for (int j = 0; j < 4; ++j) { const int n = (lane >> 3) + 8 * j; const float* s = scr + (8 * c) * 33 + n;
        u32x4 o; o.x = pk2(s[0 * 33], s[1 * 33]); o.y = pk2(s[2 * 33], s[3 * 33]); o.z = pk2(s[4 * 33], s[5 * 33]); o.w = pk2(s[6 * 33], s[7 * 33]);
        *(u32x4*)(WT + (size_t)(n0 + n) * K + k0 + 8 * c) = o; }
    LDS_WAIT(); asm volatile("" ::: "memory");
}
template <class PP> DI void phase_conv(PP p, int l, unsigned char* lds, int wave_s) {
    const int tid = opaque_tid(wave_s), lane = tid & 63, wave = tid >> 6;
    float* scr = (float*)(lds + wave * 16384);
    const int gw = blockIdx.x * 8 + wave, NGW = gridDim.x * 8;
    unsigned char* ws = p->ws;
    const float* w_in = (const float*)p->in[7] + (size_t)l * DM * DIN;
    const float* w_a = (const float*)p->in[14] + (size_t)l * 512 * DM;
    const float* w_b = (const float*)p->in[15] + (size_t)l * 256 * DM;
    const float* w_c = (const float*)p->in[16] + (size_t)l * 256 * DM;
    const float* w_o = (const float*)p->in[17] + (size_t)l * DM * DM;
    const float* w_gu = (const float*)p->in[20] + (size_t)l * DM * NGU;
    const float* w_dn = (const float*)p->in[21] + (size_t)l * DFF * DM;
    constexpr int I1 = 16 * 192, I2 = 8 * 32, I3 = 4 * 32, I4 = 4 * 32, I5 = 16 * 32, I6 = 16 * 176, I7 = 44 * 32;
    constexpr int NIT = I1 + I2 + I3 + I4 + I5 + I6 + I7;
    for (int it = gw; it < NIT; it += NGW) {
        int r = it;
        if (r < I1) { transpose_item(w_in, DIN, DM, (bf16_t*)(ws + WS_WIN), 1, scr, r, 192, lane); continue; } r -= I1;
        if (r < I2) { transpose_item(w_a, DM, DM, (bf16_t*)(ws + WS_WBA), 0, scr, r, 32, lane); continue; } r -= I2;
        if (r < I3) { transpose_item(w_b, DM, DM, (bf16_t*)(ws + WS_WBA) + 512, 0, scr, r, 32, lane); continue; } r -= I3;
        if (r < I4) { transpose_item(w_c, DM, DM, (bf16_t*)(ws + WS_WBA) + 768, 0, scr, r, 32, lane); continue; } r -= I4;
        if (r < I5) { transpose_item(w_o, DM, DM, (bf16_t*)(ws + WS_WOUT), 0, scr, r, 32, lane); continue; } r -= I5;
        if (r < I6) { transpose_item(w_gu, NGU, DM, (bf16_t*)(ws + WS_WGU), 2, scr, r, 176, lane); continue; } r -= I6;
        transpose_item(w_dn, DM, DFF, (bf16_t*)(ws + WS_WDN), 0, scr, r, 32, lane);
    }
}

struct RowArgs {
    const float* xsrc; const bf16_t* y; const float* gpost; const float* gt;
    const bf16_t* y2; const float* gpost2; const float* gt2;
    float* xdst;
    const float* gpre; const float* sc; const float* sh; bf16_t* hdst;
#ifdef PROBE_CLASS
    float probe_eps;
#endif
    const float* wfgt; const float* bfgt; float* logf;
};
DI void phase_rows(const RowArgs& a, unsigned char* lds, int wave_s) {
    const int tid = opaque_tid(wave_s), lane = tid & 63, wave = tid >> 6;
    float* wf = (float*)lds;
    if (a.wfgt) {
        for (int i = tid; i < DM * 4; i += 512) wf[i] = a.wfgt[(size_t)(i >> 2) * DIN + (i & 3)];
        __syncthreads();
    }
    const int gw = blockIdx.x * 8 + wave, NGW = gridDim.x * 8;
    for (int chunk = gw; chunk < MT / 16; chunk += NGW) {
        const int m0 = chunk * 16, b = m0 >> 11;
        f32x4 Bm[4], C[4];
#pragma unroll
        for (int j = 0; j < 4; ++j) { const int col = 4 * lane + 256 * j;
            if (a.hdst) { Bm[j] = *(const f32x4*)(a.gpre + col) * (*(const f32x4*)(a.sc + (size_t)b * 6144 + col) + 1.0f); C[j] = *(const f32x4*)(a.sh + (size_t)b * 6144 + col); } }
#pragma unroll 1
        for (int r0 = 0; r0 < 16; r0 += 4) {
            f32x4 x[4][4]; u32x2 yw[4][4];
            const size_t roff = (size_t)(m0 + r0) * DM + 4 * lane;
            const float* xb = a.xsrc + roff; const bf16_t* yb = a.y + roff; const bf16_t* y2b = a.y2 + roff; float* xo = a.xdst + roff; bf16_t* ho = a.hdst + roff;
            asm volatile("" : "+v"(xb), "+v"(yb), "+v"(y2b), "+v"(xo), "+v"(ho));
#pragma unroll
            for (int q = 0; q < 4; ++q)
#pragma unroll
                for (int j = 0; j < 4; ++j) { const int off = q * DM + 256 * j;
                    x[q][j] = __builtin_nontemporal_load((const f32x4*)(xb + off));
                    if (a.y) yw[q][j] = __builtin_nontemporal_load((const u32x2*)(yb + off)); }
            if (a.y) {
                float ss[4];
#pragma unroll
                for (int q = 0; q < 4; ++q) { ss[q] = 0.f;
#pragma unroll
                    for (int j = 0; j < 4; ++j) { const float y0 = bflo(yw[q][j].x), y1 = bfhi(yw[q][j].x), y2 = bflo(yw[q][j].y), y3 = bfhi(yw[q][j].y); ss[q] += (y0 * y0 + y1 * y1) + (y2 * y2 + y3 * y3); } }
#pragma unroll
                for (int o = 1; o < 64; o <<= 1)
#pragma unroll
                    for (int q = 0; q < 4; ++q) ss[q] += shx(ss[q], o, lane);
                f32x4 A[4];
#pragma unroll
                for (int j = 0; j < 4; ++j) { const int col = 4 * lane + 256 * j; A[j] = *(const f32x4*)(a.gpost + col) * *(const f32x4*)(a.gt + (size_t)b * 6144 + col); }
#pragma unroll
                for (int q = 0; q < 4; ++q) { const float rstd = rsqrtf(ss[q] * (1.f / DM) + RMS_EPS);
#pragma unroll
                    for (int j = 0; j < 4; ++j) { const f32x4 yv = (f32x4){bflo(yw[q][j].x), bfhi(yw[q][j].x), bflo(yw[q][j].y), bfhi(yw[q][j].y)}; x[q][j] = x[q][j] + A[j] * (yv * rstd); } }
            }
            if (a.y2) {
                u32x2 zw[4][4];
#pragma unroll
                for (int q = 0; q < 4; ++q)
#pragma unroll
                    for (int j = 0; j < 4; ++j) zw[q][j] = __builtin_nontemporal_load((const u32x2*)(y2b + q * DM + 256 * j));
                float ss[4];
#pragma unroll
                for (int q = 0; q < 4; ++q) { ss[q] = 0.f;
#pragma unroll
                    for (int j = 0; j < 4; ++j) { const float y0 = bflo(zw[q][j].x), y1 = bfhi(zw[q][j].x), y2v = bflo(zw[q][j].y), y3 = bfhi(zw[q][j].y); ss[q] += (y0 * y0 + y1 * y1) + (y2v * y2v + y3 * y3); } }
#pragma unroll
                for (int o = 1; o < 64; o <<= 1)
#pragma unroll
                    for (int q = 0; q < 4; ++q) ss[q] += shx(ss[q], o, lane);
                f32x4 A2[4];
#pragma unroll
                for (int j = 0; j < 4; ++j) { const int col = 4 * lane + 256 * j; A2[j] = *(const f32x4*)(a.gpost2 + col) * *(const f32x4*)(a.gt2 + (size_t)b * 6144 + col); }
#pragma unroll
                for (int q = 0; q < 4; ++q) { const float rstd = rsqrtf(ss[q] * (1.f / DM) + RMS_EPS);
#pragma unroll
                    for (int j = 0; j < 4; ++j) { const f32x4 yv = (f32x4){bflo(zw[q][j].x), bfhi(zw[q][j].x), bflo(zw[q][j].y), bfhi(zw[q][j].y)}; x[q][j] = x[q][j] + A2[j] * (yv * rstd); } }
            }
            if (a.xdst) {
#ifdef PROBE_CLASS
                if (a.probe_eps != 0.f && r0 == 0) {
#pragma unroll
                    for (int j = 0; j < 4; ++j) x[0][j] = x[0][j] * (1.f + a.probe_eps); }
#endif
#pragma unroll
                for (int q = 0; q < 4; ++q)
#pragma unroll
                    for (int j = 0; j < 4; ++j) __builtin_nontemporal_store(x[q][j], (f32x4*)(xo + q * DM + 256 * j));
            }
            if (a.hdst) {
                float ss[4];
#pragma unroll
                for (int q = 0; q < 4; ++q) { ss[q] = 0.f;
#pragma unroll
                    for (int j = 0; j < 4; ++j) ss[q] += (x[q][j].x * x[q][j].x + x[q][j].y * x[q][j].y) + (x[q][j].z * x[q][j].z + x[q][j].w * x[q][j].w); }
#pragma unroll
                for (int o = 1; o < 64; o <<= 1)
#pragma unroll
                    for (int q = 0; q < 4; ++q) ss[q] += shx(ss[q], o, lane);
                float lg[4][4];
#pragma unroll
                for (int q = 0; q < 4; ++q) { const float rstd = rsqrtf(ss[q] * (1.f / DM) + RMS_EPS);
                    lg[q][0] = 0.f; lg[q][1] = 0.f; lg[q][2] = 0.f; lg[q][3] = 0.f;
#pragma unroll
                    for (int j = 0; j < 4; ++j) { const int col = 4 * lane + 256 * j;
                        const f32x4 hv = x[q][j] * rstd * Bm[j] + C[j];
                        u32x2 o; o.x = pk2(hv.x, hv.y); o.y = pk2(hv.z, hv.w);
                        *(u32x2*)(ho + q * DM + 256 * j) = o;
                        if (a.wfgt) {
#pragma unroll
                            for (int e = 0; e < 4; ++e) { const f32x4 w4 = *(const f32x4*)(wf + (col + e) * 4); const float hh = hv[e];
                                lg[q][0] += hh * w4.x; lg[q][1] += hh * w4.y; lg[q][2] += hh * w4.z; lg[q][3] += hh * w4.w; } } } }
                if (a.wfgt) {
#pragma unroll
                    for (int o = 1; o < 64; o <<= 1)
#pragma unroll
                        for (int q = 0; q < 4; ++q)
#pragma unroll
                            for (int e = 0; e < 4; ++e) lg[q][e] += shx(lg[q][e], o, lane);
                    if (lane < 16) { const int q = lane >> 2, e = lane & 3; float z = 0.f;
#pragma unroll
                        for (int qq = 0; qq < 4; ++qq)
#pragma unroll
                            for (int ee = 0; ee < 4; ++ee) z = (q == qq && e == ee) ? lg[qq][ee] : z;
                        z += a.bfgt[e];
                        const float lf = fminf(z, 0.f) - __logf(1.f + __expf(-fabsf(z)));
                        a.logf[(size_t)(b * 4 + e) * SEQ + ((m0 + r0 + q) & (SEQ - 1))] = lf; }
                }
            }
        }
    }
}
struct EpiIn {
    static constexpr bool PERM = true, AFTER_DRAIN = false, KHOOK = false;
    bf16_t* qkv; bf16_t* gate; const int* pos;
    DI void operator()(const f32x4 (&acc)[2][2][4][2], const pg8::Unit& u, int wr, int wc, int fr, int fq) const {
        const int pn = u.pn, row0 = u.pm * 256 + wr * 64 + fr;
        if (pn >= 12) {
            const int col0 = (pn - 12) * 256 + wc * 32 + 8 * fq;
#pragma unroll
            for (int ai = 0; ai < 2; ++ai)
#pragma unroll
                for (int m = 0; m < 4; ++m) { bf16_t* rowp = gate + (size_t)(row0 + ai * 128 + m * 16) * 3072 + col0;
#pragma unroll
                    for (int bj = 0; bj < 2; ++bj) { const f32x4 v0 = acc[ai][bj][m][0], v1 = acc[ai][bj][m][1]; float s[8];
#pragma unroll
                        for (int e = 0; e < 4; ++e) { s[e] = 1.f / (1.f + __expf(-v0[e])); s[4 + e] = 1.f / (1.f + __expf(-v1[e])); }
                        u32x4 w; w.x = pk2(s[0], s[1]); w.y = pk2(s[2], s[3]); w.z = pk2(s[4], s[5]); w.w = pk2(s[6], s[7]);
                        __builtin_nontemporal_store(w, (u32x4*)(rowp + bj * 128)); } }
        } else if (pn == 4 || pn == 5 || pn == 8 || pn == 11) {
            const bool wide = (pn <= 5);
            const size_t toff = wide ? VA_OFF : (pn == 8 ? VB_OFF : VC_OFF);
            const int DV = wide ? 128 : 64;
            const int b = u.pm >> 3, sbase = (u.pm & 7) * 256 + wr * 64;
            const int hh = (fr >> 2) & 1, j = ((fr >> 3) << 2) | (fr & 3);
#pragma unroll
            for (int bj = 0; bj < 2; ++bj) {
                const int head = wide ? (2 * (pn - 4) + bj) : (2 * bj + (wc >> 1));
                const int dbase = wide ? (32 * wc + 8 * fq) : (32 * (wc & 1) + 8 * fq);
                const int bh = b * 4 + head;
#pragma unroll
                for (int ai = 0; ai < 2; ++ai)
#pragma unroll
                    for (int m = 0; m < 4; ++m) { const int s = sbase + ai * 128 + m * 16, tile = s >> 5, st = m & 1;
                        bf16_t* bp = qkv + toff + ((size_t)(((bh * 64 + tile) * 2 + st) * 2 + hh) * DV + dbase) * 8 + j;
#pragma unroll
                        for (int n = 0; n < 2; ++n) { const f32x4 v = acc[ai][bj][m][n];
                            const unsigned w0 = pk2(v[0], v[1]), w1 = pk2(v[2], v[3]);
                            bp[(4 * n + 0) * 8] = (bf16_t)(w0 & 0xffffu); bp[(4 * n + 1) * 8] = (bf16_t)(w0 >> 16);
                            bp[(4 * n + 2) * 8] = (bf16_t)(w1 & 0xffffu); bp[(4 * n + 3) * 8] = (bf16_t)(w1 >> 16); } }
            }
        } else {
            const bool rope = !(pn == 6 || pn == 7);
            size_t toff; int NH, hbase;
            if (pn <= 1) { toff = QA_OFF; NH = 8; hbase = 4 * (pn & 1); }
            else if (pn <= 3) { toff = KA_OFF; NH = 8; hbase = 4 * (pn & 1); }
            else if (pn == 6) { toff = QB_OFF; NH = 4; hbase = 0; }
            else if (pn == 7) { toff = KB_OFF; NH = 4; hbase = 0; }
            else if (pn == 9) { toff = QC_OFF; NH = 4; hbase = 0; }
            else { toff = KC_OFF; NH = 4; hbase = 0; }
            const int b = u.pm >> 3, sbase = (u.pm & 7) * 256 + wr * 64 + fr;
            const int c0 = 32 * (wc & 1) + 8 * fq;
            float invf[4];
#pragma unroll
            for (int e = 0; e < 4; ++e) invf[e] = __builtin_amdgcn_exp2f(-(float)(16 * (wc & 1) + 4 * fq + e) * (13.287712379549449f / 32.0f));
#pragma unroll
            for (int ai = 0; ai < 2; ++ai)
#pragma unroll
                for (int m = 0; m < 4; ++m) { const int s = sbase + ai * 128 + m * 16;
                    float cs[4], sn[4];
                    if (rope) { const float pf = (float)pos[b * SEQ + s];
#pragma unroll
                        for (int e = 0; e < 4; ++e) { float t = (pf * invf[e]) * 0.15915494309189535f; t = t - floorf(t); sn[e] = __builtin_amdgcn_sinf(t); cs[e] = __builtin_amdgcn_cosf(t); } }
                    else {
#pragma unroll
                        for (int e = 0; e < 4; ++e) { cs[e] = 1.f; sn[e] = 0.f; } }
#pragma unroll
                    for (int bj = 0; bj < 2; ++bj) { const int head = hbase + 2 * bj + (wc >> 1);
                        const f32x4 x1 = acc[ai][bj][m][0], x2 = acc[ai][bj][m][1]; float o1[4], o2[4];
#pragma unroll
                        for (int e = 0; e < 4; ++e) { o1[e] = x1[e] * cs[e] - x2[e] * sn[e]; o2[e] = x2[e] * cs[e] + x1[e] * sn[e]; }
                        u32x4 w; w.x = pk2(o1[0], o1[1]); w.y = pk2(o1[2], o1[3]); w.z = pk2(o2[0], o2[1]); w.w = pk2(o2[2], o2[3]);
                        *(u32x4*)(qkv + toff + ((size_t)((b * NH + head) * SEQ + s)) * 64 + c0) = w; } }
        }
    }
};
template <int PASS> struct EpiMerge {
    static constexpr bool PERM = true, AFTER_DRAIN = false, KHOOK = false;
    const bf16_t* gate; bf16_t* merged;
    DI void operator()(const f32x4 (&acc)[2][2][4][2], const pg8::Unit& u, int wr, int wc, int fr, int fq) const {
        const int row0 = u.pm * 256 + wr * 64 + fr, col0 = u.pn * 256 + wc * 32 + 8 * fq;
#pragma unroll
        for (int ai = 0; ai < 2; ++ai)
#pragma unroll
            for (int m = 0; m < 4; ++m) { const size_t row = (size_t)(row0 + ai * 128 + m * 16);
#pragma unroll
                for (int bj = 0; bj < 2; ++bj) { const int col = col0 + bj * 128;
                    const u32x4 g = *(const u32x4*)(gate + row * 3072 + PASS * 1024 + col);
                    f32x4 v0 = acc[ai][bj][m][0] * (f32x4){bflo(g.x), bfhi(g.x), bflo(g.y), bfhi(g.y)};
                    f32x4 v1 = acc[ai][bj][m][1] * (f32x4){bflo(g.z), bfhi(g.z), bflo(g.w), bfhi(g.w)};
                    bf16_t* mp = merged + row * DM + col;
                    if (PASS > 0) { const u32x4 pv = *(const u32x4*)mp; v0 = v0 + (f32x4){bflo(pv.x), bfhi(pv.x), bflo(pv.y), bfhi(pv.y)}; v1 = v1 + (f32x4){bflo(pv.z), bfhi(pv.z), bflo(pv.w), bfhi(pv.w)}; }
                    u32x4 w; w.x = pk2(v0[0], v0[1]); w.y = pk2(v0[2], v0[3]); w.z = pk2(v1[0], v1[1]); w.w = pk2(v1[2], v1[3]);
                    *(u32x4*)mp = w; } }
    }
};
struct EpiMergeK {
    static constexpr bool PERM = true, AFTER_DRAIN = false, KHOOK = true;
    const bf16_t* gate; bf16_t* merged;
    static DI f32x4 lo4(const u32x4 g) { return (f32x4){bflo(g.x), bfhi(g.x), bflo(g.y), bfhi(g.y)}; }
    static DI f32x4 hi4(const u32x4 g) { return (f32x4){bflo(g.z), bfhi(g.z), bflo(g.w), bfhi(g.w)}; }
    static DI f32x4 clampg(f32x4 v) { return (f32x4){fmaxf(v[0], 1e-18f), fmaxf(v[1], 1e-18f), fmaxf(v[2], 1e-18f), fmaxf(v[3], 1e-18f)}; }
    static DI f32x4 rcp4(f32x4 v) { return (f32x4){__builtin_amdgcn_rcpf(v[0]), __builtin_amdgcn_rcpf(v[1]), __builtin_amdgcn_rcpf(v[2]), __builtin_amdgcn_rcpf(v[3])}; }
    DI void khook(f32x4 (&acc)[2][2][4][2], const pg8::Unit& u, int t, int wr, int wc, int fr, int fq) const {
        if (t != 8 && t != 12) return;
        const bf16_t* gp0 = gate + (size_t)(u.pm * 256 + wr * 64 + fr) * 3072 + (t == 8 ? 0 : 1024) + u.pn * 256 + wc * 32 + 8 * fq;
        asm volatile("" : "+v"(gp0));
        u32x4 dummy = {0u, 0u, 0u, 0u};
#define PF_LD(P, OFF) asm volatile("global_load_dwordx4 %0, %1, off offset:" #OFF : "+v"(dummy) : "v"(P) : "memory")
        if (t == 8) {
#pragma unroll
        for (int ai = 0; ai < 2; ++ai)
#pragma unroll
            for (int m = 0; m < 4; ++m) { const bf16_t* pp = gp0 + 2048 + (size_t)(ai * 128 + m * 16) * 3072; PF_LD(pp, 0); PF_LD(pp, 256); }
        }
#undef PF_LD
#pragma unroll
        for (int ai = 0; ai < 2; ++ai)
            {
                u32x4 gn[4][2], gd[4][2];
#pragma unroll
                for (int m = 0; m < 4; ++m)
#pragma unroll
                    for (int bj = 0; bj < 2; ++bj) { const bf16_t* gp = gp0 + (size_t)(ai * 128 + m * 16) * 3072 + bj * 128; gn[m][bj] = *(const u32x4*)gp; gd[m][bj] = *(const u32x4*)(gp + 1024); }
#pragma unroll
                for (int m = 0; m < 4; ++m)
#pragma unroll
                    for (int bj = 0; bj < 2; ++bj) {
                        acc[ai][bj][m][0] = acc[ai][bj][m][0] * (clampg(lo4(gn[m][bj])) * rcp4(clampg(lo4(gd[m][bj]))));
                        acc[ai][bj][m][1] = acc[ai][bj][m][1] * (clampg(hi4(gn[m][bj])) * rcp4(clampg(hi4(gd[m][bj])))); }
                asm volatile("" : "+v"(acc[ai][0][0][0]), "+v"(acc[ai][0][0][1]), "+v"(acc[ai][1][0][0]), "+v"(acc[ai][1][0][1]), "+v"(acc[ai][0][1][0]), "+v"(acc[ai][0][1][1]), "+v"(acc[ai][1][1][0]), "+v"(acc[ai][1][1][1]),
                             "+v"(acc[ai][0][2][0]), "+v"(acc[ai][0][2][1]), "+v"(acc[ai][1][2][0]), "+v"(acc[ai][1][2][1]), "+v"(acc[ai][0][3][0]), "+v"(acc[ai][0][3][1]), "+v"(acc[ai][1][3][0]), "+v"(acc[ai][1][3][1]) :: "memory"); }
        asm volatile("s_waitcnt vmcnt(0)" : "+v"(dummy) :: "memory");
    }
    DI void operator()(const f32x4 (&acc)[2][2][4][2], const pg8::Unit& u, int wr, int wc, int fr, int fq) const {
        const int row0 = u.pm * 256 + wr * 64 + fr, col0 = u.pn * 256 + wc * 32 + 8 * fq;
#pragma unroll
        for (int ai = 0; ai < 2; ++ai)
#pragma unroll
            for (int m = 0; m < 4; ++m) { const size_t row = (size_t)(row0 + ai * 128 + m * 16);
#pragma unroll
                for (int bj = 0; bj < 2; ++bj) { const int col = col0 + bj * 128;
                    const u32x4 g = *(const u32x4*)(gate + row * 3072 + 2 * 1024 + col);
                    const f32x4 v0 = acc[ai][bj][m][0] * clampg(lo4(g)), v1 = acc[ai][bj][m][1] * clampg(hi4(g));
                    u32x4 w; w.x = pk2(v0[0], v0[1]); w.y = pk2(v0[2], v0[3]); w.z = pk2(v1[0], v1[1]); w.w = pk2(v1[2], v1[3]);
                    *(u32x4*)(merged + row * DM + col) = w; } }
    }
};
struct EpiPlain {
    static constexpr bool PERM = true, AFTER_DRAIN = false, KHOOK = false;
    bf16_t* O; int ldc;
    DI void operator()(const f32x4 (&acc)[2][2][4][2], const pg8::Unit& u, int wr, int wc, int fr, int fq) const {
        const int row0 = u.pm * 256 + wr * 64 + fr, col0 = u.pn * 256 + wc * 32 + 8 * fq;
#pragma unroll
        for (int ai = 0; ai < 2; ++ai)
#pragma unroll
            for (int m = 0; m < 4; ++m) { bf16_t* rowp = O + (size_t)(row0 + ai * 128 + m * 16) * ldc + col0;
#pragma unroll
                for (int bj = 0; bj < 2; ++bj) { const f32x4 v0 = acc[ai][bj][m][0], v1 = acc[ai][bj][m][1];
                    u32x4 w; w.x = pk2(v0[0], v0[1]); w.y = pk2(v0[2], v0[3]); w.z = pk2(v1[0], v1[1]); w.w = pk2(v1[2], v1[3]);
                    *(u32x4*)(rowp + bj * 128) = w; } }
    }
};
struct EpiSwiglu {
    static constexpr bool PERM = true, AFTER_DRAIN = false, KHOOK = false;
    bf16_t* act;
    DI void operator()(const f32x4 (&acc)[2][2][4][2], const pg8::Unit& u, int wr, int wc, int fr, int fq) const {
        const int row0 = u.pm * 256 + wr * 64 + fr, col0 = u.pn * 128 + wc * 16 + 4 * fq;
#pragma unroll
        for (int ai = 0; ai < 2; ++ai)
#pragma unroll
            for (int m = 0; m < 4; ++m) { bf16_t* rowp = act + (size_t)(row0 + ai * 128 + m * 16) * DFF + col0;
#pragma unroll
                for (int bj = 0; bj < 2; ++bj) { const f32x4 a = acc[ai][bj][m][0], bv = acc[ai][bj][m][1]; float r[4];
#pragma unroll
                    for (int e = 0; e < 4; ++e) r[e] = a[e] / (1.f + __expf(-a[e])) * bv[e];
                    u32x2 w; w.x = pk2(r[0], r[1]); w.y = pk2(r[2], r[3]);
                    *(u32x2*)(rowp + bj * 64) = w; } }
    }
};

DI void phase_mini(const float* logf, float* cum, const bf16_t* kc, float* kmean, unsigned* ctl, const bf16_t* kbf, unsigned* kmax, int wave_s) {
    const int tid = opaque_tid(wave_s), lane = tid & 63, wave = tid >> 6;
    if (blockIdx.x == 0 && tid == 0) ctl[0] = 0u;
    const int gw = blockIdx.x * 8 + wave, NGW = gridDim.x * 8;
    for (int it = gw; it < 64 + 512 + 512; it += NGW) {
        if (it >= 64 + 512) {
            const int idx = it - 576, bh = idx >> 3, n = idx & 7;
            const bf16_t* kp = kbf + ((size_t)bh * SEQ + n * 256 + (lane >> 3)) * 64 + 8 * (lane & 7);
            float mxn = 0.f;
#pragma unroll 4
            for (int i = 0; i < 32; ++i) { const u32x4 w = *(const u32x4*)(kp + (size_t)(8 * i) * 64);
                float s = bflo(w.x) * bflo(w.x) + bfhi(w.x) * bfhi(w.x) + bflo(w.y) * bflo(w.y) + bfhi(w.y) * bfhi(w.y) + bflo(w.z) * bflo(w.z) + bfhi(w.z) * bfhi(w.z) + bflo(w.w) * bflo(w.w) + bfhi(w.w) * bfhi(w.w);
                s += shx(s, 1, lane); s += shx(s, 2, lane); s += shx(s, 4, lane);
                mxn = fmaxf(mxn, s); }
#pragma unroll
            for (int o = 8; o < 64; o <<= 1) mxn = fmaxf(mxn, shx(mxn, o, lane));
            if (lane == 0) atomicMax(kmax + bh, __float_as_uint(mxn));
            continue;
        }
        if (it < 64) {
            const float* src = logf + (size_t)it * SEQ + lane * 32; float* dst = cum + (size_t)it * SEQ + lane * 32;
            f32x4 v[8]; float run = 0.f;
#pragma unroll
            for (int j = 0; j < 8; ++j) { v[j] = *(const f32x4*)(src + 4 * j); v[j].x += run; v[j].y += v[j].x; v[j].z += v[j].y; v[j].w += v[j].z; run = v[j].w; }
            float incl = run;
#pragma unroll
            for (int o = 1; o < 64; o <<= 1) { const int srcl = lane >= o ? lane - o : lane; const float t = __int_as_float(__builtin_amdgcn_ds_bpermute(srcl << 2, __float_as_int(incl))); if (lane >= o) incl += t; }
            const float excl = incl - run;
#pragma unroll
            for (int j = 0; j < 8; ++j) *(f32x4*)(dst + 4 * j) = (v[j] + excl) * LOG2E;
        } else {
            const int idx = it - 64, bh = idx >> 3, n = idx & 7;
            const bf16_t* kp = kc + ((size_t)bh * SEQ + n * 256 + (lane >> 3)) * 64 + 8 * (lane & 7);
            float s[8];
#pragma unroll
            for (int e = 0; e < 8; ++e) s[e] = 0.f;
#pragma unroll 8
            for (int i = 0; i < 32; ++i) { const u32x4 w = *(const u32x4*)(kp + (size_t)(8 * i) * 64);
                s[0] += bflo(w.x); s[1] += bfhi(w.x); s[2] += bflo(w.y); s[3] += bfhi(w.y); s[4] += bflo(w.z); s[5] += bfhi(w.z); s[6] += bflo(w.w); s[7] += bfhi(w.w); }
#pragma unroll
            for (int o = 8; o < 64; o <<= 1)
#pragma unroll
                for (int e = 0; e < 8; ++e) s[e] += shx(s[e], o, lane);
            if (lane < 8) {
                float* kd = kmean + (size_t)idx * 64 + 8 * lane;
                *(f32x4*)kd = (f32x4){s[0], s[1], s[2], s[3]} * (1.f / 256.f); *(f32x4*)(kd + 4) = (f32x4){s[4], s[5], s[6], s[7]} * (1.f / 256.f); }
        }
    }
}

#define MFMA32(a, b, c) __builtin_amdgcn_mfma_f32_32x32x16_bf16((a), (b), (c), 0, 0, 0)
DI float xmax32(float v) { const auto r = __builtin_amdgcn_permlane32_swap(__float_as_uint(v), __float_as_uint(v), false, false); return fmaxf(__uint_as_float(r[0]), __uint_as_float(r[1])); }
DI float xsum32(float v) { const auto r = __builtin_amdgcn_permlane32_swap(__float_as_uint(v), __float_as_uint(v), false, false); return __uint_as_float(r[0]) + __uint_as_float(r[1]); }
constexpr int AT_KV = 65536, AT_KB = 9216;
#define ABAR() do { asm volatile("s_waitcnt lgkmcnt(0)" ::: "memory"); __builtin_amdgcn_s_barrier(); asm volatile("" ::: "memory"); } while (0)
template <int DT, int MODE>
DI void attn_stream(const bf16_t* __restrict__ Qh, const bf16_t* __restrict__ Kh, const bf16_t* __restrict__ Vt, const int qb, const int wave, const int lane, const int tid,
                    unsigned char* lds, f32x16 (&O)[DT], float& l_out, const float* __restrict__ cum, const float* __restrict__ kmean, const float kmax2) {
    constexpr int DV = DT * 32;
    const int r = lane & 31, h = lane >> 5;
    const int q0 = qb * 256 + wave * 32;
    const float SCL = 0.125f * LOG2E;
    bf16x8 qf[4];
#pragma unroll
    for (int c = 0; c < 4; ++c) qf[c] = *(const bf16x8*)(Qh + (size_t)(q0 + r) * 64 + h * 32 + c * 8);
    const int last = q0 >> 6, own = qb, wg_last = 4 * qb + 3;
    unsigned sel = 0u, anysel = 0u, wg_any = 0u;
    if (MODE == 2) {
        if (own <= 3) sel = (1u << own) - 1u;
        else {
            float g[7];
#pragma unroll
            for (int n = 0; n < 7; ++n) {
                float part = 0.f;
                if (n < own) {
#pragma unroll
                    for (int c = 0; c < 4; ++c) { const float* kmp = kmean + n * 64 + h * 32 + c * 8; const f32x4 k0 = *(const f32x4*)kmp, k1 = *(const f32x4*)(kmp + 4);
                        const u32x4 qw = __builtin_bit_cast(u32x4, qf[c]);
                        part += bflo(qw.x) * k0.x + bfhi(qw.x) * k0.y + bflo(qw.y) * k0.z + bfhi(qw.y) * k0.w + bflo(qw.z) * k1.x + bfhi(qw.z) * k1.y + bflo(qw.w) * k1.z + bfhi(qw.w) * k1.w; }
                    part += shx(part, 32, lane);
                } else part = -3.0e38f;
                g[n] = part;
            }
#pragma unroll
            for (int t = 0; t < 3; ++t) { float bv = -3.4e38f; int best = 0;
#pragma unroll
                for (int n = 0; n < 7; ++n) { const bool ok = (n < own) && !((sel >> n) & 1u) && (g[n] > bv); bv = ok ? g[n] : bv; best = ok ? n : best; }
                sel |= 1u << best; }
        }
        const unsigned long long b0 = __ballot((sel >> 0) & 1u), b1 = __ballot((sel >> 1) & 1u), b2 = __ballot((sel >> 2) & 1u), b3 = __ballot((sel >> 3) & 1u),
                                 b4 = __ballot((sel >> 4) & 1u), b5 = __ballot((sel >> 5) & 1u), b6 = __ballot((sel >> 6) & 1u);
        anysel = (b0 ? 1u : 0u) | (b1 ? 2u : 0u) | (b2 ? 4u : 0u) | (b3 ? 8u : 0u) | (b4 ? 16u : 0u) | (b5 ? 32u : 0u) | (b6 ? 64u : 0u);
        volatile unsigned* aw = (volatile unsigned*)(lds + LDS_MISC + 128);
        if (lane == 0) aw[wave] = anysel;
        __syncthreads();
#pragma unroll
        for (int w = 0; w < 8; ++w) wg_any |= aw[w];
    }
    float cql = 0.f;
    if (MODE == 1) cql = cum[q0 + r];
    float m_run = -1.0e30f, l_run = 0.f;
#pragma unroll
    for (int dt = 0; dt < DT; ++dt)
#pragma unroll
        for (int i = 0; i < 16; ++i) O[dt][i] = 0.f;

    auto nxt = [&](int kt) -> int {
        int k = kt + 1;
        if (MODE == 2) { while (k < own * 4 && !((wg_any >> (k >> 2)) & 1u)) k = ((k >> 2) + 1) * 4; }
        return k;
    };
    constexpr int AT_BUF = AT_KB + DT * 4096;
    const float* cuml = (const float*)(lds + AT_KV + 2 * AT_BUF);
    if (MODE == 1) *(f32x4*)(lds + AT_KV + 2 * AT_BUF + tid * 16) = *(const f32x4*)(cum + tid * 4);
    struct Stage { u32x4 k; u32x4 v[DT / 2]; };
    Stage sA, sB;
    auto gload = [&](int kt_, Stage& s) {
        const int kt = kt_ < 0 ? 0 : (kt_ < wg_last ? kt_ : wg_last);
        s.k = *(const u32x4*)(Kh + (size_t)kt * 4096 + tid * 8);
#pragma unroll
        for (int j = 0; j < DT / 2; ++j) s.v[j] = *(const u32x4*)(Vt + (size_t)kt * 64 * DV + j * 4096 + tid * 8);
    };
    auto lstore = [&](int buf, const Stage& s) {
        unsigned char* bp = lds + AT_KV + buf * AT_BUF;
        *(u32x4*)(bp + (tid >> 3) * 144 + (tid & 7) * 16) = s.k;
#pragma unroll
        for (int j = 0; j < DT / 2; ++j) *(u32x4*)(bp + AT_KB + j * 8192 + tid * 16) = s.v[j];
    };
    auto compute = [&](const int kt, const int cur) {
        const bool mine = (kt <= last) && (MODE != 2 || (kt >> 2) >= own || ((anysel >> (kt >> 2)) & 1u));
        if (mine) {
            const unsigned char* bp = lds + AT_KV + cur * AT_BUF;
            f32x16 S[2];
            {
                bf16x8 kf[2][4];
#pragma unroll
                for (int s2 = 0; s2 < 2; ++s2)
#pragma unroll
                    for (int c = 0; c < 4; ++c) kf[s2][c] = *(const bf16x8*)(bp + (s2 * 32 + r) * 144 + h * 64 + c * 16);
                asm volatile("" : "+v"(kf[0][0]), "+v"(kf[0][1]), "+v"(kf[0][2]), "+v"(kf[0][3]), "+v"(kf[1][0]), "+v"(kf[1][1]), "+v"(kf[1][2]), "+v"(kf[1][3]));
#pragma unroll
                for (int s2 = 0; s2 < 2; ++s2) {
#pragma unroll
                    for (int i = 0; i < 16; ++i) S[s2][i] = 0.f;
#pragma unroll
                    for (int c = 0; c < 4; ++c) S[s2] = MFMA32(kf[s2][c], qf[c], S[s2]);
                }
            }
#ifdef EXP_LDS2X
            {
#pragma unroll
                for (int s2 = 0; s2 < 2; ++s2) {
#pragma unroll
                    for (int c = 0; c < 4; ++c) { bf16x8 d = *(const volatile bf16x8*)(bp + (s2 * 32 + r) * 144 + h * 64 + c * 16); asm volatile("" :: "v"(d)); }
#pragma unroll
                    for (int st = 0; st < 2; ++st)
#pragma unroll
                        for (int dt = 0; dt < DT; ++dt) { bf16x8 d = *(const volatile bf16x8*)(bp + AT_KB + s2 * (DT * 2048) + (((st * 2 + h) * DV) + dt * 32 + r) * 16); asm volatile("" :: "v"(d)); }
                }
            }
#endif
            const bool diag = (kt == last);
            bool rowsel = true, rowmask = false;
            if (MODE == 2) { const int n = kt >> 2; if (n < own) { rowsel = ((sel >> n) & 1u) != 0u; rowmask = true; } }
            float t[2][16];
#pragma unroll
            for (int s2 = 0; s2 < 2; ++s2) {
                if (MODE == 1) {
#pragma unroll
                    for (int g = 0; g < 4; ++g) { const f32x4 ck = *(const f32x4*)(cuml + kt * 64 + s2 * 32 + 8 * g + 4 * h);
#pragma unroll
                        for (int e = 0; e < 4; ++e) t[s2][4 * g + e] = __builtin_fmaf(S[s2][4 * g + e], SCL, cql - ck[e]); }
                } else {
#pragma unroll
                    for (int i = 0; i < 16; ++i) t[s2][i] = S[s2][i];
                }
            }
            if (diag) {
                const int lim = (q0 - kt * 64) + r;
#pragma unroll
                for (int s2 = 0; s2 < 2; ++s2)
#pragma unroll
                    for (int i = 0; i < 16; ++i) { const int kr = s2 * 32 + (i & 3) + 8 * (i >> 2) + 4 * h; t[s2][i] = (kr <= lim) ? t[s2][i] : -1.0e30f; }
            }
            float mx = fmaxf(t[0][0], t[1][0]);
#pragma unroll
            for (int i = 1; i < 16; ++i) mx = fmaxf(mx, fmaxf(t[0][i], t[1][i]));
            mx = xmax32(mx);
            float cand = (MODE == 1) ? mx : mx * SCL;
            if (rowmask) cand = rowsel ? cand : m_run;
            if (__builtin_amdgcn_ballot_w64(cand > m_run + 8.0f) != 0ull) {
                const float m_nw = fmaxf(m_run, cand);
                const float alpha = __builtin_amdgcn_exp2f(m_run - m_nw);
                l_run *= alpha;
#pragma unroll
                for (int dt = 0; dt < DT; ++dt)
#pragma unroll
                    for (int i = 0; i < 16; ++i) O[dt][i] *= alpha;
                m_run = m_nw;
            }
            const float m_new = m_run;
            float p[2][16]; float ls = 0.f;
#pragma unroll
            for (int s2 = 0; s2 < 2; ++s2)
#pragma unroll
                for (int i = 0; i < 16; ++i) p[s2][i] = __builtin_amdgcn_exp2f((MODE == 1) ? (t[s2][i] - m_new) : __builtin_fmaf(t[s2][i], SCL, -m_new));
            if (diag) {
#pragma unroll
                for (int s2 = 0; s2 < 2; ++s2)
#pragma unroll
                    for (int i = 0; i < 16; ++i) p[s2][i] = (t[s2][i] <= -1.0e29f) ? 0.f : p[s2][i];
            }
            if (rowmask) {
#pragma unroll
                for (int s2 = 0; s2 < 2; ++s2)
#pragma unroll
                    for (int i = 0; i < 16; ++i) p[s2][i] = rowsel ? p[s2][i] : 0.f;
            }
#pragma unroll
            for (int i = 0; i < 16; ++i) ls += p[0][i] + p[1][i];
            l_run += ls;
#pragma unroll
            for (int s2 = 0; s2 < 2; ++s2) {
                bf16x8 vf[2][DT];
#pragma unroll
                for (int st = 0; st < 2; ++st)
#pragma unroll
                    for (int dt = 0; dt < DT; ++dt) vf[st][dt] = *(const bf16x8*)(bp + AT_KB + s2 * (DT * 2048) + (((st * 2 + h) * DV) + dt * 32 + r) * 16);
                if constexpr (DT == 4) asm volatile("" : "+v"(vf[0][0]), "+v"(vf[0][1]), "+v"(vf[0][2]), "+v"(vf[0][DT - 1]), "+v"(vf[1][0]), "+v"(vf[1][1]), "+v"(vf[1][2]), "+v"(vf[1][DT - 1]));
                else asm volatile("" : "+v"(vf[0][0]), "+v"(vf[0][1]), "+v"(vf[1][0]), "+v"(vf[1][1]));
#pragma unroll
                for (int st = 0; st < 2; ++st) {
                    u32x4 pw; pw.x = pk2(p[s2][8 * st + 0], p[s2][8 * st + 1]); pw.y = pk2(p[s2][8 * st + 2], p[s2][8 * st + 3]); pw.z = pk2(p[s2][8 * st + 4], p[s2][8 * st + 5]); pw.w = pk2(p[s2][8 * st + 6], p[s2][8 * st + 7]);
                    const bf16x8 pf = __builtin_bit_cast(bf16x8, pw);
#pragma unroll
                    for (int dt = 0; dt < DT; ++dt) O[dt] = MFMA32(vf[st][dt], pf, O[dt]);
                }
            }
        }
    };
    if (MODE == 1) {
        float qn2 = 0.f;
#pragma unroll
        for (int c = 0; c < 4; ++c) { const u32x4 qw = __builtin_bit_cast(u32x4, qf[c]);
            qn2 += bflo(qw.x) * bflo(qw.x) + bfhi(qw.x) * bfhi(qw.x) + bflo(qw.y) * bflo(qw.y) + bfhi(qw.y) * bfhi(qw.y) + bflo(qw.z) * bflo(qw.z) + bfhi(qw.z) * bfhi(qw.z) + bflo(qw.w) * bflo(qw.w) + bfhi(qw.w) * bfhi(qw.w); }
        qn2 += shx(qn2, 32, lane);
        const float qkb = sqrtf(qn2 * kmax2) * SCL * 1.001f + 127.0f;
        volatile unsigned* fl = (volatile unsigned*)(lds + LDS_MISC + 160);
        bool done = false;
        int kt = wg_last, cur = 0, par = 0;
        gload(kt, sA); lstore(0, sA);
        int ka = kt - 1;
        gload(ka, sA);
        asm volatile("" : "+v"(qf[0]), "+v"(qf[1]), "+v"(qf[2]), "+v"(qf[3]), "+v"(cql));
        ABAR();
        auto step_done = [&](const int k) {
            if (!done && k <= last) {
                if (k == 0) done = true;
                else { const float bmax = cql - cuml[k * 64 - 1]; const bool ok = (qkb + bmax) < m_run; done = (__builtin_amdgcn_ballot_w64(!ok) == 0ull); }
            }
        };
        for (;;) {
            const int kb = ka - 1;
            gload(kb, sB);
            if (!done) compute(kt, cur);
            step_done(kt);
            if (lane == 0) fl[par * 8 + wave] = done ? 0u : 1u;
            lstore(cur ^ 1, sA);
            ABAR();
            { unsigned any = 0u;
#pragma unroll
              for (int w = 0; w < 8; ++w) any |= fl[par * 8 + w];
              par ^= 1;
              if (ka < 0 || any == 0u) break; }
            const int kc = kb - 1;
            gload(kc, sA);
            if (!done) compute(ka, cur ^ 1);
            step_done(ka);
            if (lane == 0) fl[par * 8 + wave] = done ? 0u : 1u;
            lstore(cur, sB);
            ABAR();
            { unsigned any = 0u;
#pragma unroll
              for (int w = 0; w < 8; ++w) any |= fl[par * 8 + w];
              par ^= 1;
              if (kb < 0 || any == 0u) break; }
            kt = kb; ka = kc;
        }
    } else {
        int kt = nxt(-1), cur = 0;
        gload(kt, sA); lstore(0, sA);
        int ka = nxt(kt);
        gload(ka, sA);
        asm volatile("" : "+v"(qf[0]), "+v"(qf[1]), "+v"(qf[2]), "+v"(qf[3]), "+v"(cql));
        ABAR();
        for (;;) {
            const int kb = nxt(ka);
            gload(kb, sB);
            compute(kt, cur);
            lstore(cur ^ 1, sA);
            ABAR();
            if (ka > wg_last) break;
            const int kc = nxt(kb);
            gload(kc, sA);
            compute(ka, cur ^ 1);
            lstore(cur, sB);
            ABAR();
            if (kb > wg_last) break;
            kt = kb; ka = kc;
        }
    }
    l_out = xsum32(l_run);
}

struct AttnArgs { const bf16_t* qkv; bf16_t* oa; bf16_t* ob; bf16_t* oc; const float* cum; const float* kmean; const float* gsub; float lam, lam_init; unsigned* ctl; const unsigned* kmax; };
DI void phase_attn(const AttnArgs& a, unsigned char* lds, int wave_s) {
    const int tid = opaque_tid(wave_s), lane0 = tid & 63, wave = tid >> 6;
    volatile unsigned* bc = (volatile unsigned*)(lds + LDS_MISC);
    unsigned* stash = (unsigned*)(lds + wave * 8192);
    for (;;) {
        if (tid == 0) bc[0] = atomicAdd(a.ctl, 1u);
        __syncthreads();
        const unsigned u = bc[0];
        __syncthreads();
        if (u >= 1536u) break;
        int lane = lane0; asm volatile("" : "+v"(lane));
        const int r = lane & 31, h = lane >> 5;
        if (u < 512u) {
            const int qb = 7 - (int)(u >> 6), bh = (int)(u & 63u), b = bh >> 2, head = bh & 3;
            const int q0 = qb * 256 + wave * 32;
            const bf16_t* Vt = a.qkv + VA_OFF + (size_t)bh * SEQ * 128;
#pragma unroll 1
            for (int half = 0; half < 2; ++half) {
                f32x16 O[4]; float l;
                attn_stream<4, 0>(a.qkv + QA_OFF + (size_t)(b * 8 + 2 * head + half) * SEQ * 64, a.qkv + KA_OFF + (size_t)(b * 8 + 2 * head + half) * SEQ * 64, Vt, qb, wave, lane, tid, lds, O, l, nullptr, nullptr, 0.f);
                if (half == 0) {
                    const float inv = 1.f / l;
#pragma unroll
                    for (int dt = 0; dt < 4; ++dt) {
#pragma unroll
                        for (int i = 0; i < 16; i += 2) stash[(dt * 8 + (i >> 1)) * 64 + lane] = pk2(O[dt][i] * inv, O[dt][i + 1] * inv);
                        asm volatile("" ::: "memory"); }
                } else {
                    const float inv = a.lam / l; float ss = 0.f;
#pragma unroll
                    for (int dt = 0; dt < 4; ++dt) {
#pragma unroll
                        for (int i = 0; i < 16; i += 2) { const unsigned w = stash[(dt * 8 + (i >> 1)) * 64 + lane]; const float o0 = bflo(w) - O[dt][i] * inv, o1 = bfhi(w) - O[dt][i + 1] * inv; O[dt][i] = o0; O[dt][i + 1] = o1; ss += o0 * o0 + o1 * o1; }
                        asm volatile("" ::: "memory"); }
                    ss += shx(ss, 32, lane);
                    const float rstd = rsqrtf(ss * (1.f / 128.f) + RMS_EPS) * (1.f - a.lam_init);
                    bf16_t* op = a.oa + (size_t)(b * SEQ + q0 + r) * DM + head * 128;
#pragma unroll
                    for (int dt = 0; dt < 4; ++dt) {
#pragma unroll
                        for (int g = 0; g < 4; ++g) { const int d = dt * 32 + 8 * g + 4 * h; const f32x4 gs = *(const f32x4*)(a.gsub + d);
                            u32x2 w; w.x = pk2(O[dt][4 * g] * rstd * gs.x, O[dt][4 * g + 1] * rstd * gs.y); w.y = pk2(O[dt][4 * g + 2] * rstd * gs.z, O[dt][4 * g + 3] * rstd * gs.w);
                            *(u32x2*)(op + d) = w; }
                        asm volatile("" ::: "memory"); }
                }
            }
        } else {
            const unsigned v = u - 512u; const int qb = 7 - (int)(v >> 7), w7 = (int)(v & 127u), typ = 1 + (w7 >> 6), bh = w7 & 63, b = bh >> 2, head = bh & 3;
            const int q0 = qb * 256 + wave * 32;
            f32x16 O[2]; float l;
            bf16_t* op;
            if (typ == 1) {
                attn_stream<2, 1>(a.qkv + QB_OFF + (size_t)bh * SEQ * 64, a.qkv + KB_OFF + (size_t)bh * SEQ * 64, a.qkv + VB_OFF + (size_t)bh * SEQ * 64, qb, wave, lane, tid, lds, O, l, a.cum + (size_t)bh * SEQ, nullptr, __uint_as_float(a.kmax[bh]));
                op = a.oa + (size_t)(b * SEQ + q0 + r) * DM + 512 + head * 64;
            } else {
                attn_stream<2, 2>(a.qkv + QC_OFF + (size_t)bh * SEQ * 64, a.qkv + KC_OFF + (size_t)bh * SEQ * 64, a.qkv + VC_OFF + (size_t)bh * SEQ * 64, qb, wave, lane, tid, lds, O, l, nullptr, a.kmean + (size_t)bh * 8 * 64, 0.f);
                op = a.oa + (size_t)(b * SEQ + q0 + r) * DM + 768 + head * 64;
            }
            const float inv = 1.f / l;
#pragma unroll
            for (int dt = 0; dt < 2; ++dt)
#pragma unroll
                for (int g = 0; g < 4; ++g) { const int d = dt * 32 + 8 * g + 4 * h;
                    u32x2 w; w.x = pk2(O[dt][4 * g] * inv, O[dt][4 * g + 1] * inv); w.y = pk2(O[dt][4 * g + 2] * inv, O[dt][4 * g + 3] * inv);
                    *(u32x2*)(op + d) = w; }
        }
    }
}

#define XB_TMO      128
#define XB_XCNT(j)  (256  + 64 * (j))
#define XB_XSUB(j)  (1280 + 64 * (j))
#define XB_XGEN(j)  (2304 + 64 * (j))
#define XB_TOP      3328
#define XB_TOPGEN   3392
#define XCD_BAR_WORDS 3456
#define XB_SPIN_CAP (1u << 18)

__device__ __forceinline__ unsigned xb_ld(unsigned* p)              { return __hip_atomic_load(p, __ATOMIC_RELAXED, __HIP_MEMORY_SCOPE_AGENT); }
__device__ __forceinline__ unsigned xb_add(unsigned* p, unsigned v) { return __hip_atomic_fetch_add(p, v, __ATOMIC_RELAXED, __HIP_MEMORY_SCOPE_AGENT); }
__device__ __forceinline__ unsigned xb_xcc_id() { return (unsigned)__builtin_amdgcn_s_getreg((3 << 11) | 20) & 0xFu; }
#define XB_SPIN(cond, bar) do { unsigned _sp = 0; while (cond) { __builtin_amdgcn_s_sleep(1); \
    if ((++_sp & 255u) == 0u) { if (xb_ld(&(bar)[XB_TMO])) break; if (_sp > XB_SPIN_CAP) { atomicAdd(&(bar)[XB_TMO], 1u); break; } } } } while (0)

struct XcdBarrier {
    unsigned* bar; unsigned x;
    volatile LAS unsigned* st;
};

__device__ __forceinline__ XcdBarrier xcd_barrier_post(unsigned* bar, volatile LAS unsigned* st, int tid) {
    XcdBarrier b; b.bar = bar; b.x = xb_xcc_id(); b.st = st;
    if (tid == 0) (void)xb_add(&bar[XB_XCNT(b.x)], 1u);
    return b;
}
__device__ __forceinline__ void xcd_barrier_complete(unsigned* bar, unsigned x, unsigned& nloc, unsigned& nx) {
    const unsigned G = gridDim.x * gridDim.y * gridDim.z;
    unsigned sum, cnt, mine, sp = 0u;
    for (;;) {
        sum = 0u; cnt = 0u; mine = 0u;
#pragma unroll
        for (unsigned j = 0; j < 16; ++j) { const unsigned c = xb_ld(&bar[XB_XCNT(j)]); sum += c; cnt += (c > 0u) ? 1u : 0u; mine = (j == x) ? c : mine; }
        if (sum == G) break;
        __builtin_amdgcn_s_sleep(1);
        if ((++sp & 255u) == 0u) { if (xb_ld(&bar[XB_TMO])) break; if (sp > XB_SPIN_CAP) { atomicAdd(&bar[XB_TMO], 1u); break; } }
    }
    nloc = mine > 0u ? mine : 1u; nx = cnt > 0u ? cnt : 1u;
}

__device__ __forceinline__ void xcd_barrier(const XcdBarrier& b, int tid) {
    asm volatile("s_waitcnt vmcnt(0)" ::: "memory");
    __syncthreads();
    if (tid == 0) {
        unsigned* bar = b.bar;
        __builtin_amdgcn_s_waitcnt(0);
        unsigned nloc = b.st[0], nx = b.st[1];
        if (nloc == 0u) { xcd_barrier_complete(bar, b.x, nloc, nx); b.st[0] = nloc; b.st[1] = nx; }
        const unsigned old = xb_add(&bar[XB_XSUB(b.x)], 1u);
        const unsigned gen = old / nloc;
        if (old + 1u == (gen + 1u) * nloc) {
            __builtin_amdgcn_fence(__ATOMIC_RELEASE, "agent");
            asm volatile("s_waitcnt vmcnt(0)" ::: "memory");
            const unsigned og = xb_add(&bar[XB_TOP], 1u);
            const unsigned tg = og / nx;
            if (og + 1u == (tg + 1u) * nx) xb_add(&bar[XB_TOPGEN], 1u);
            else XB_SPIN(xb_ld(&bar[XB_TOPGEN]) == tg, bar);
            __builtin_amdgcn_fence(__ATOMIC_ACQUIRE, "agent");
            xb_add(&bar[XB_XGEN(b.x)], 1u);
            asm volatile("s_waitcnt vmcnt(0)" ::: "memory");
        } else {
            XB_SPIN(xb_ld(&bar[XB_XGEN(b.x)]) == gen, bar);
            __builtin_amdgcn_fence(__ATOMIC_ACQUIRE, "agent");
            asm volatile("s_waitcnt vmcnt(0)" ::: "memory");
        }
    }
    __syncthreads();
}

typedef const Params __attribute__((address_space(4))) CParams;
DI CParams* fresh_params() { CParams* kp = (CParams*)__builtin_amdgcn_kernarg_segment_ptr(); asm volatile("" : "+s"(kp)); return kp; }
#define PHASE_BEGIN CParams* kp = fresh_params(); unsigned char* ws = kp->ws; (void)ws;
#define PIN(i) (kp->in[i])
#define MODP ((float*)(ws + WS_MOD))
#ifdef PROBE_CLASS
#define PLDS ((volatile unsigned long long*)(lds + LDS_MISC + 64))
#define PROBE_T0() do { if (blockIdx.x == 0 && opaque_tid(wave_s) == 0) PLDS[0] = __builtin_amdgcn_s_memrealtime(); } while (0)
#define PROBE_T1(cls) do { if ((cls) == PROBE_CLASS && blockIdx.x == 0 && opaque_tid(wave_s) == 0) PLDS[1] += __builtin_amdgcn_s_memrealtime() - PLDS[0]; } while (0)
#else
#define PROBE_T0() do { } while (0)
#define PROBE_T1(cls) do { } while (0)
#endif
__global__ void __launch_bounds__(512, 2) fwd_megakernel(Params p) {
    extern __shared__ __attribute__((aligned(16))) unsigned char lds[];
    cg::grid_group grid = cg::this_grid();
    const int wave_s = __builtin_amdgcn_readfirstlane((int)(threadIdx.x >> 6));
    {
        volatile LAS unsigned* st = (volatile LAS unsigned*)(lds + LDS_MISC + 256);
        if (opaque_tid(wave_s) == 0) { st[0] = 0u; st[1] = 0u; }
        __syncthreads();
    }
    (void)xcd_barrier_post((unsigned*)(fresh_params()->ws + WS_BAR), (volatile LAS unsigned*)(lds + LDS_MISC + 256), opaque_tid(wave_s));
#define GSYNC() do { XcdBarrier xb_; xb_.bar = (unsigned*)(fresh_params()->ws + WS_BAR); xb_.x = xb_xcc_id(); xb_.st = (volatile LAS unsigned*)(lds + LDS_MISC + 256); xcd_barrier(xb_, opaque_tid(wave_s)); } while (0)
#ifdef PROBE_CLASS
    if (blockIdx.x == 0 && opaque_tid(wave_s) == 0) PLDS[1] = 0ull;
#endif
    PROBE_T0();
    {
        PHASE_BEGIN
#ifndef NO_P0
        phase_mod((const float*)PIN(1), (const float*)PIN(3), (const float*)PIN(4), MODP, lds, wave_s);
        __syncthreads();
        phase_conv(kp, 0, lds, wave_s);
#endif
    }
    if (gridDim.x == 0x7fffffffu) grid.sync();
    GSYNC();
    PROBE_T1(0); PROBE_T0();
#ifdef EXP_SYNC
    for (int i = 0; i < 20; ++i) { GSYNC(); }
    PROBE_T1(9); PROBE_T0();
#endif
    {
        PHASE_BEGIN
        RowArgs a{};
        a.xsrc = (const float*)PIN(0); a.y = nullptr; a.gpost = nullptr; a.gt = nullptr; a.y2 = nullptr; a.gpost2 = nullptr; a.gt2 = nullptr; a.xdst = nullptr;
        a.gpre = (const float*)PIN(5); a.sc = MODP + 1 * DM; a.sh = MODP + 0 * DM; a.hdst = (bf16_t*)(ws + WS_H);
        a.wfgt = (const float*)PIN(7) + 6144; a.bfgt = (const float*)PIN(8); a.logf = (float*)(ws + WS_LOGF);
        phase_rows(a, lds, wave_s);
    }
    GSYNC();
    PROBE_T1(1); PROBE_T0();
#pragma unroll 1
    for (int l = 0; l < 2; ++l) {
        {
            PHASE_BEGIN
            pg8::Gemm g{(const bf16_t*)(ws + WS_H), (const bf16_t*)(ws + WS_WIN), MT, NQG, DM}; pg8::StaticOrder S; S.init(MT, NQG, (int)gridDim.x, (int)blockIdx.x);
            EpiIn E{(bf16_t*)(ws + WS_QKV), (bf16_t*)(ws + WS_GATE), (const int*)PIN(2)};
            pg8::gemm_phase<EpiIn, pg8::StaticOrder, true, true>((PG8_LAS unsigned char*)lds, g, S, E, opaque_tid(wave_s));
        }
        GSYNC();
        PROBE_T1(2); PROBE_T0();
        {
            PHASE_BEGIN
            phase_mini((const float*)(ws + WS_LOGF), (float*)(ws + WS_CUM), (const bf16_t*)(ws + WS_QKV) + KC_OFF, (float*)(ws + WS_KMEAN), (unsigned*)(ws + WS_CTL), (const bf16_t*)(ws + WS_QKV) + KB_OFF, (unsigned*)(ws + WS_CTL + 2048) + l * 64, wave_s);
        }
        GSYNC();
        PROBE_T1(3); PROBE_T0();
        {
            PHASE_BEGIN
            const int lane = opaque_tid(wave_s) & 63;
            const float lam_init = (l == 0) ? 0.2f : 0.35550906759f;
            const float q1 = ((const float*)PIN(9))[l * 64 + lane], k1 = ((const float*)PIN(10))[l * 64 + lane];
            const float q2 = ((const float*)PIN(11))[l * 64 + lane], k2 = ((const float*)PIN(12))[l * 64 + lane];
            const float lam = __expf(wave_sum(q1 * k1, lane)) - __expf(wave_sum(q2 * k2, lane)) + lam_init;
            AttnArgs a{(const bf16_t*)(ws + WS_QKV), (bf16_t*)(ws + WS_OA), (bf16_t*)(ws + WS_OB), (bf16_t*)(ws + WS_OC), (const float*)(ws + WS_CUM), (const float*)(ws + WS_KMEAN),
                       (const float*)PIN(13) + l * 128, lam, lam_init, (unsigned*)(ws + WS_CTL), (const unsigned*)(ws + WS_CTL + 2048) + l * 64};
#ifndef NO_ATTN
            phase_attn(a, lds, wave_s);
#endif
        }
        GSYNC();
        PROBE_T1(4); PROBE_T0();
        {
            PHASE_BEGIN
            pg8::StaticOrder S; S.init(MT, DM, (int)gridDim.x, (int)blockIdx.x);
            pg8::Gemm g{(const bf16_t*)(ws + WS_OA), (const bf16_t*)(ws + WS_WBA), MT, DM, DM}; EpiMergeK E{(const bf16_t*)(ws + WS_GATE), (bf16_t*)(ws + WS_MERGED)};
            pg8::gemm_phase<EpiMergeK, pg8::StaticOrder, true, true>((PG8_LAS unsigned char*)lds, g, S, E, opaque_tid(wave_s));
        }
        GSYNC();
        PROBE_T1(5); PROBE_T0();
        {
            PHASE_BEGIN
            pg8::Gemm g{(const bf16_t*)(ws + WS_MERGED), (const bf16_t*)(ws + WS_WOUT), MT, DM, DM}; pg8::StaticOrder S; S.init(MT, DM, (int)gridDim.x, (int)blockIdx.x);
            EpiPlain E{(bf16_t*)(ws + WS_Y), DM};
            pg8::gemm_phase<EpiPlain, pg8::StaticOrder, true, true>((PG8_LAS unsigned char*)lds, g, S, E, opaque_tid(wave_s));
        }
        GSYNC();
        PROBE_T1(6); PROBE_T0();
        {
            PHASE_BEGIN
            const float* modl = MODP + (size_t)l * 16 * 6144;
            RowArgs a{};
            a.xsrc = (l == 0) ? (const float*)PIN(0) : (const float*)kp->out; a.y = (const bf16_t*)(ws + WS_Y); a.gpost = (const float*)PIN(6) + l * DM; a.gt = modl + 2 * DM; a.xdst = nullptr;
            a.y2 = nullptr; a.gpost2 = nullptr; a.gt2 = nullptr;
            a.gpre = (const float*)PIN(18) + l * DM; a.sc = modl + 4 * DM; a.sh = modl + 3 * DM; a.hdst = (bf16_t*)(ws + WS_H);
            a.wfgt = nullptr; a.bfgt = nullptr; a.logf = nullptr;
            phase_rows(a, lds, wave_s);
        }
        GSYNC();
        PROBE_T1(1); PROBE_T0();
        {
            PHASE_BEGIN
            pg8::Gemm g{(const bf16_t*)(ws + WS_H), (const bf16_t*)(ws + WS_WGU), MT, NGU, DM}; pg8::StaticOrder S; S.init(MT, NGU, (int)gridDim.x, (int)blockIdx.x);
            EpiSwiglu E{(bf16_t*)(ws + WS_ACT)};
            pg8::gemm_phase<EpiSwiglu, pg8::StaticOrder, true, true>((PG8_LAS unsigned char*)lds, g, S, E, opaque_tid(wave_s));
        }
        GSYNC();
        PROBE_T1(7); PROBE_T0();
        {
            PHASE_BEGIN
            pg8::Gemm g{(const bf16_t*)(ws + WS_ACT), (const bf16_t*)(ws + WS_WDN), MT, DM, DFF}; pg8::StaticOrder S; S.init(MT, DM, (int)gridDim.x, (int)blockIdx.x);
            EpiPlain E{(bf16_t*)(ws + WS_DN), DM};
            pg8::gemm_phase<EpiPlain, pg8::StaticOrder, true, true>((PG8_LAS unsigned char*)lds, g, S, E, opaque_tid(wave_s));
        }
        GSYNC();
        PROBE_T1(8); PROBE_T0();
        {
            PHASE_BEGIN
            const float* modl = MODP + (size_t)l * 16 * 6144;
            RowArgs a{};
            a.xsrc = (l == 0) ? (const float*)PIN(0) : (const float*)kp->out; a.y = (const bf16_t*)(ws + WS_Y); a.gpost = (const float*)PIN(6) + l * DM; a.gt = modl + 2 * DM;
            a.y2 = (const bf16_t*)(ws + WS_DN); a.gpost2 = (const float*)PIN(19) + l * DM; a.gt2 = modl + 5 * DM; a.xdst = kp->out;
            if (l == 0) {
                const float* mod1 = MODP + (size_t)16 * 6144;
                a.gpre = (const float*)PIN(5) + DM; a.sc = mod1 + 1 * DM; a.sh = mod1 + 0 * DM; a.hdst = (bf16_t*)(ws + WS_H);
                a.wfgt = (const float*)PIN(7) + (size_t)DM * DIN + 6144; a.bfgt = (const float*)PIN(8) + 4; a.logf = (float*)(ws + WS_LOGF);
            } else { a.gpre = nullptr; a.sc = nullptr; a.sh = nullptr; a.hdst = nullptr; a.wfgt = nullptr; a.bfgt = nullptr; a.logf = nullptr; }
#ifdef PROBE_CLASS
            if (l == 1) {
                if (blockIdx.x == 0 && opaque_tid(wave_s) == 0) *(volatile unsigned long long*)(ws + WS_CTL + 512) = PLDS[1];
                GSYNC();
                const unsigned long long ticks = *(volatile unsigned long long*)(ws + WS_CTL + 512);
                a.probe_eps = sqrtf((float)ticks * 0.01f * 4.8e-7f);
            }
#endif
            phase_rows(a, lds, wave_s);
            if (l == 0) {
                __syncthreads();
#ifndef NO_P0
                phase_conv(kp, 1, lds, wave_s);
#endif
            }
        }
        if (l == 0) { GSYNC(); PROBE_T1(1); PROBE_T0(); }
    }
}

extern "C" void kernel_launch(void* const* d_in, const int* in_sizes, int n_in, void* d_out, int out_size, void* d_ws, size_t ws_size, hipStream_t stream) {
    static int grid = 0;
    if (grid == 0) {
        if (n_in != 22 || out_size != MT * DM || ws_size < WS_END) { fprintf(stderr, "kernel_launch: unexpected problem (n_in %d, out %d, ws %zu)\n", n_in, out_size, ws_size); grid = -1; return; }
        int dev = 0, cus = 0, per_cu = 0;
        if (hipGetDevice(&dev) != hipSuccess || hipDeviceGetAttribute(&cus, hipDeviceAttributeMultiprocessorCount, dev) != hipSuccess) { grid = -1; return; }
        if (hipFuncSetAttribute((const void*)fwd_megakernel, hipFuncAttributeMaxDynamicSharedMemorySize, LDS_BYTES) != hipSuccess) { fprintf(stderr, "kernel_launch: hipFuncSetAttribute failed\n"); grid = -1; return; }
        if (hipOccupancyMaxActiveBlocksPerMultiprocessor(&per_cu, (const void*)fwd_megakernel, 512, LDS_BYTES) != hipSuccess || per_cu < 1) { fprintf(stderr, "kernel_launch: occupancy query says %d\n", per_cu); per_cu = 1; }
        (void)hipGetLastError();
        grid = cus * 1;
    }
    if (grid < 0) return;
    if (hipMemsetAsync((char*)d_ws + WS_CTL, 0, 65536, stream) != hipSuccess) { fprintf(stderr, "kernel_launch: memset failed\n"); return; }
    Params p{};
    for (int i = 0; i < 22; ++i) p.in[i] = d_in[i];
    p.out = (float*)d_out; p.ws = (unsigned char*)d_ws;
    void* args[] = {&p};
    const hipError_t e = hipLaunchCooperativeKernel((const void*)fwd_megakernel, dim3(grid), dim3(512), args, LDS_BYTES, stream);
    if (e != hipSuccess) fprintf(stderr, "kernel_launch: cooperative launch failed: %s (grid %d)\n", hipGetErrorString(e), grid);
}
```

```cpp
#include <hip/hip_runtime.h>
#include <hip/hip_cooperative_groups.h>
#include <cstdio>
#include <cstdint>
#include <type_traits>
namespace cg = cooperative_groups;
namespace pg8 {
#define PG8_LAS __attribute__((address_space(3)))
typedef unsigned short bf16_t;
typedef short bf16x8 __attribute__((ext_vector_type(8)));
typedef float f32x4 __attribute__((ext_vector_type(4)));
typedef unsigned u32x4 __attribute__((ext_vector_type(4)));
constexpr int BM = 256, BK = 64, HALF = 128, HTB = HALF * BK * 2  , STAGE_BYTES = 8 * HTB, NXCD = 8, WGM = 8;

__host__ __device__ __forceinline__ int lds_byte(int r, int c) { const int st = (r >> 4) * 2 + (c >> 5), rr = r & 15, cc = c & 31, ob = rr * 64 + cc * 2; return st * 1024 + (ob ^ (((ob >> 9) & 1) << 5)); }
__host__ __device__ __forceinline__ void stage_rc(int b, int& R, int& C) { const int st = b / 1024, sb = b % 1024, swz = sb ^ (((sb >> 9) & 1) << 5); R = (st >> 1) * 16 + swz / 64; C = (st & 1) * 32 + (swz % 64) / 2; }
__host__ __device__ __forceinline__ int perm32(int rho) { const int n = rho >> 4, i = rho & 15; return 8 * (i >> 2) + 4 * n + (i & 3); }

struct Unit { int pm, pn; };
struct Gemm { const bf16_t* A; const bf16_t* Bt; int M, N, K; };

struct StaticOrder {
    int nM, nN, nwg, G, c;
    __host__ __device__ void init(int M, int N, int G_, int c_) { nM = M / BM; nN = N / BM; nwg = nM * nN; G = G_; c = c_; }
    __host__ __device__ bool next(int i, Unit& u) const {
        const long L = (long)i * G + c; if (L >= nwg) return false;
        int wgid = (int)L; { const int q = nwg / NXCD, r = nwg % NXCD, xcd = wgid % NXCD, off = wgid / NXCD; wgid = (xcd < r ? xcd * (q + 1) : r * (q + 1) + (xcd - r) * q) + off; }
        const int nig = WGM * nN, gid = wgid / nig, fm = gid * WGM, gsz = (nM - fm) < WGM ? (nM - fm) : WGM;
        u.pm = fm + ((wgid % nig) % gsz); u.pn = (wgid % nig) / gsz; return true;
    }
    __device__ __forceinline__ void a_ready(const Unit&) const {}
    __device__ __forceinline__ void done(const Unit&) const {}
};

__device__ __forceinline__ unsigned cvt_pk_bf16(float lo, float hi) { unsigned r; asm volatile("v_cvt_pk_bf16_f32 %0, %1, %2" : "=v"(r) : "v"(lo), "v"(hi)); return r; }
template <class Epi, class Sched, bool ALIGN_EPI = false, bool SP2 = false>
__device__ __forceinline__ void gemm_phase(PG8_LAS unsigned char* lds, const Gemm g, const Sched& S, const Epi& E, const int tid_in) {
    int tid_ = tid_in; asm volatile("" : "+v"(tid_));
    const int tid = tid_, wid = __builtin_amdgcn_readfirstlane(tid >> 6), lane = tid & 63, wr = wid >> 2, wc = wid & 3, fr = lane & 15, fq = lane >> 4;
    const int K = g.K, nt = K / BK;
    unsigned voffA[2], voffB[2];
#pragma unroll
    for (int i = 0; i < 2; ++i) { int R, C; stage_rc(tid * 16 + i * 8192, R, C); const int Rb = Epi::PERM ? ((R & ~31) + perm32(R & 31)) : R;
        voffA[i] = (unsigned)(R * K + C) * 2u; voffB[i] = (unsigned)(Rb * K + C) * 2u; }
    const size_t kstep = (size_t)(BK * 2);
    const size_t hstep = (size_t)HALF * K * 2;
    const size_t tstep = 2 * hstep;
    const unsigned ldsw = (unsigned)wid * 1024u;
    const int aoff = lds_byte(wr * 64 + fr, fq * 8), boff = lds_byte(wc * 32 + fr, fq * 8);
#define PG8_SA(b, h) (((b) * 2 + (h)) * HTB)
#define PG8_SB(b, h) ((4 + (b) * 2 + (h)) * HTB)
#define PG8_STAGE(bufoff, gbase, voff) do { _Pragma("unroll") for (int _i = 0; _i < 2; ++_i) \
        __builtin_amdgcn_global_load_lds((const unsigned*)((const char*)(gbase) + (voff)[_i]), (PG8_LAS unsigned*)(lds + (bufoff) + ldsw + _i * 8192), 16, 0, 0); } while (0)
#define PG8_LDA(dst, b, h) do { _Pragma("unroll") for (int m = 0; m < 4; ++m) _Pragma("unroll") for (int k = 0; k < 2; ++k) dst[m][k] = *(const PG8_LAS bf16x8*)(lds + PG8_SA(b, h) + aoff + m * 2048 + k * 1024); } while (0)
#define PG8_LDB(dst, b, h) do { _Pragma("unroll") for (int n = 0; n < 2; ++n) _Pragma("unroll") for (int k = 0; k < 2; ++k) dst[n][k] = *(const PG8_LAS bf16x8*)(lds + PG8_SB(b, h) + boff + n * 2048 + k * 1024); } while (0)
#define PG8_MMA(ai, bj, At, Bt) do { __builtin_amdgcn_s_setprio(1); _Pragma("unroll") for (int m = 0; m < 4; ++m) _Pragma("unroll") for (int n = 0; n < 2; ++n) _Pragma("unroll") for (int k = 0; k < 2; ++k) \
        acc[ai][bj][m][n] = __builtin_amdgcn_mfma_f32_16x16x32_bf16(Bt[n][k], At[m][k], acc[ai][bj][m][n], 0, 0, 0); __builtin_amdgcn_s_setprio(0); } while (0)
#define PG8_WAIT_V(n) asm volatile("s_waitcnt vmcnt(" #n ")" ::: "memory")
#define PG8_WAIT_L(n) asm volatile("s_waitcnt lgkmcnt(" #n ")" ::: "memory")
#define PG8_BAR __builtin_amdgcn_s_barrier()
#define PG8_SCHED __builtin_amdgcn_sched_barrier(0)
    Unit cur, nxt; int ui = 0;
    if (!S.next(0, cur)) return;
    f32x4 acc[2][2][4][2];
#pragma unroll
    for (int a = 0; a < 2; ++a)
#pragma unroll
        for (int b = 0; b < 2; ++b)
#pragma unroll
            for (int m = 0; m < 4; ++m)
#pragma unroll
                for (int n = 0; n < 2; ++n) acc[a][b][m][n] = (f32x4){0.f, 0.f, 0.f, 0.f};
    bf16x8 At[4][2], B0[2][2], B1[2][2];
    const char* cA = (const char*)g.A + (size_t)cur.pm * tstep; const char* cB = (const char*)g.Bt + (size_t)cur.pn * tstep;
    S.a_ready(cur);
    if constexpr (SP2) {
        PG8_STAGE(PG8_SB(0, 0), cB, voffB); PG8_STAGE(PG8_SB(0, 1), cB + hstep, voffB); PG8_STAGE(PG8_SA(0, 0), cA, voffA); PG8_STAGE(PG8_SA(0, 1), cA + hstep, voffA);
        if (wr == 1) PG8_BAR;
        PG8_WAIT_V(2); PG8_BAR;
        PG8_STAGE(PG8_SB(1, 0), cB + kstep, voffB); PG8_STAGE(PG8_SA(1, 0), cA + kstep, voffA); PG8_STAGE(PG8_SB(1, 1), cB + hstep + kstep, voffB);
        PG8_WAIT_V(6); PG8_BAR;
    } else {
        PG8_STAGE(PG8_SB(0, 0), cB, voffB); PG8_STAGE(PG8_SA(0, 0), cA, voffA); PG8_STAGE(PG8_SB(0, 1), cB + hstep, voffB); PG8_STAGE(PG8_SA(0, 1), cA + hstep, voffA);
        if (wr == 1) PG8_BAR;
        PG8_WAIT_V(4); PG8_BAR;
        PG8_STAGE(PG8_SB(1, 0), cB + kstep, voffB); PG8_STAGE(PG8_SA(1, 0), cA + kstep, voffA); PG8_STAGE(PG8_SB(1, 1), cB + hstep + kstep, voffB);
        PG8_WAIT_V(6); PG8_BAR;
    }
    for (;;) {
        const bool has_next = S.next(ui + 1, nxt);
        const char* nA = has_next ? (const char*)g.A + (size_t)nxt.pm * tstep : cA; const char* nB = has_next ? (const char*)g.Bt + (size_t)nxt.pn * tstep : cB;
        for (int t = 0; t < nt; t += 2) {
            if constexpr (Epi::KHOOK) E.khook(acc, cur, t, wr, wc, fr, fq);
            const bool last = (t == nt - 2);
            const char* a1 = cA + (size_t)(t + 1) * kstep;
            const char* a2 = last ? nA : cA + (size_t)(t + 2) * kstep; const char* b2 = last ? nB : cB + (size_t)(t + 2) * kstep;
            const char* a3 = a2 + kstep; const char* b3 = b2 + kstep;
            if (last && has_next) S.a_ready(nxt);
            if constexpr (SP2) {
            PG8_LDB(B0, 0, 0); PG8_LDB(B1, 0, 1); PG8_SCHED; PG8_LDA(At, 0, 0); PG8_STAGE(PG8_SA(1, 1), a1 + hstep, voffA);
            PG8_WAIT_V(8); PG8_WAIT_L(0); PG8_BAR; PG8_MMA(0, 0, At, B0); PG8_MMA(0, 1, At, B1); PG8_BAR; PG8_SCHED;
            PG8_LDA(At, 0, 1); PG8_STAGE(PG8_SB(0, 0), b2, voffB); PG8_STAGE(PG8_SB(0, 1), b2 + hstep, voffB); PG8_STAGE(PG8_SA(0, 0), a2, voffA);
            PG8_WAIT_V(8); PG8_WAIT_L(0); PG8_BAR; PG8_MMA(1, 0, At, B0); PG8_MMA(1, 1, At, B1); PG8_BAR; PG8_SCHED;
            PG8_LDB(B0, 1, 0); PG8_LDB(B1, 1, 1); PG8_SCHED; PG8_LDA(At, 1, 0); PG8_STAGE(PG8_SA(0, 1), a2 + hstep, voffA);
            PG8_WAIT_V(8); PG8_WAIT_L(0); PG8_BAR; PG8_MMA(0, 0, At, B0); PG8_MMA(0, 1, At, B1); PG8_BAR; PG8_SCHED;
            PG8_LDA(At, 1, 1); PG8_STAGE(PG8_SB(1, 0), b3, voffB); PG8_STAGE(PG8_SB(1, 1), b3 + hstep, voffB); PG8_STAGE(PG8_SA(1, 0), a3, voffA);
            PG8_WAIT_V(8); PG8_WAIT_L(0); PG8_BAR; PG8_MMA(1, 0, At, B0); PG8_MMA(1, 1, At, B1); PG8_BAR; PG8_SCHED;
            } else {
            PG8_LDB(B0, 0, 0); PG8_SCHED; PG8_LDA(At, 0, 0); PG8_STAGE(PG8_SA(1, 1), a1 + hstep, voffA);
            PG8_WAIT_L(8); PG8_BAR; PG8_WAIT_L(0); PG8_MMA(0, 0, At, B0); PG8_BAR; PG8_SCHED;
            PG8_LDB(B1, 0, 1); PG8_STAGE(PG8_SB(0, 0), b2, voffB);
            PG8_BAR; PG8_WAIT_L(0); PG8_MMA(0, 1, At, B1); PG8_BAR;
            PG8_LDA(At, 0, 1); PG8_STAGE(PG8_SA(0, 0), a2, voffA);
            PG8_BAR; PG8_WAIT_L(0); PG8_MMA(1, 0, At, B0); PG8_BAR; PG8_SCHED;
            PG8_STAGE(PG8_SB(0, 1), b2 + hstep, voffB);
            PG8_WAIT_V(6); PG8_BAR; PG8_MMA(1, 1, At, B1); PG8_BAR;
            PG8_LDB(B0, 1, 0); PG8_SCHED; PG8_LDA(At, 1, 0); PG8_STAGE(PG8_SA(0, 1), a2 + hstep, voffA);
            PG8_WAIT_L(8); PG8_BAR; PG8_WAIT_L(0); PG8_MMA(0, 0, At, B0); PG8_BAR; PG8_SCHED;
            PG8_LDB(B1, 1, 1); PG8_STAGE(PG8_SB(1, 0), b3, voffB);
            PG8_BAR; PG8_WAIT_L(0); PG8_MMA(0, 1, At, B1); PG8_BAR;
            PG8_LDA(At, 1, 1); PG8_STAGE(PG8_SA(1, 0), a3, voffA);
            PG8_BAR; PG8_WAIT_L(0); PG8_MMA(1, 0, At, B0); PG8_BAR; PG8_SCHED;
            PG8_STAGE(PG8_SB(1, 1), b3 + hstep, voffB);
            PG8_WAIT_V(6); PG8_BAR; PG8_MMA(1, 1, At, B1); PG8_BAR;
            }
        }
        if constexpr (ALIGN_EPI) { if (wr == 0) PG8_BAR; }
        if constexpr (!Epi::AFTER_DRAIN) { E(acc, cur, wr, wc, fr, fq); S.done(cur); }
        if (!has_next) break;
#pragma unroll
        for (int a = 0; a < 2; ++a)
#pragma unroll
            for (int b = 0; b < 2; ++b)
#pragma unroll
                for (int m = 0; m < 4; ++m)
#pragma unroll
                    for (int n = 0; n < 2; ++n) acc[a][b][m][n] = (f32x4){0.f, 0.f, 0.f, 0.f};
        cur = nxt; cA = nA; cB = nB; ++ui;
        if constexpr (ALIGN_EPI) { if (wr == 1) PG8_BAR; }
    }
    PG8_WAIT_V(0);
    if constexpr (!ALIGN_EPI) { if (wr == 0) PG8_BAR; }
    PG8_BAR;
    if constexpr (Epi::AFTER_DRAIN) { E.fused(acc, cur, wr, wc, fr, fq, lds, wid, lane); S.done(cur); }
#undef PG8_SA
#undef PG8_SB
#undef PG8_STAGE
#undef PG8_LDA
#undef PG8_LDB
#undef PG8_MMA
#undef PG8_WAIT_V
#undef PG8_WAIT_L
#undef PG8_BAR
#undef PG8_SCHED
}
}
using pg8::bf16_t; using pg8::bf16x8; using pg8::f32x4; using pg8::u32x4;
#define DI __device__ __forceinline__
#define LAS __attribute__((address_space(3)))
typedef float f32x16 __attribute__((ext_vector_type(16)));
typedef float f32x2 __attribute__((ext_vector_type(2)));
typedef unsigned u32x2 __attribute__((ext_vector_type(2)));
typedef __bf16 bf16v2 __attribute__((ext_vector_type(2)));

constexpr int NB = 16, SEQ = 2048, DM = 1024, MT = NB * SEQ, DIN = 6148, NQG = 6144, DFF = 2816, NGU = 5632;
constexpr float RMS_EPS = 1e-6f, LOG2E = 1.4426950408889634f;
constexpr size_t MiB = 1u << 20;
constexpr size_t WS_CTL = 0, WS_BAR = 16384, WS_MOD = 1 * MiB, WS_LOGF = 2 * MiB, WS_CUM = 2 * MiB + 512 * 1024, WS_KMEAN = 3 * MiB;
constexpr size_t WS_WIN = 4 * MiB, WS_WBA = 16 * MiB, WS_WBB = 17 * MiB, WS_WBC = 17 * MiB + 512 * 1024, WS_WOUT = 18 * MiB, WS_WGU = 20 * MiB, WS_WDN = 31 * MiB;
constexpr size_t WS_H = 40 * MiB, WS_OA = WS_H, WS_OB = WS_H + 32 * MiB, WS_OC = WS_H + 48 * MiB;
constexpr size_t WS_QKV = 104 * MiB, WS_M32 = WS_QKV, WS_MERGED = WS_QKV + 128 * MiB, WS_Y = WS_QKV, WS_DN = WS_QKV + 64 * MiB;
constexpr size_t WS_GATE = 296 * MiB, WS_ACT = WS_GATE, WS_END = 488 * MiB;
constexpr size_t EL = 524288;
constexpr size_t QA_OFF = 0, KA_OFF = 32 * EL, VA_OFF = 64 * EL, QB_OFF = 96 * EL, KB_OFF = 112 * EL, VB_OFF = 128 * EL, QC_OFF = 144 * EL, KC_OFF = 160 * EL, VC_OFF = 176 * EL;
constexpr int LDS_BYTES = 163840, LDS_MISC = 163840 - 512;

DI unsigned pk2(float a, float b) { f32x2 v = {a, b}; bf16v2 r = __builtin_convertvector(v, bf16v2); return __builtin_bit_cast(unsigned, r); }
DI float bflo(unsigned w) { return __uint_as_float(w << 16); }
DI float bfhi(unsigned w) { return __uint_as_float(w & 0xffff0000u); }
DI float shx(float v, int mask, int lane) { return __int_as_float(__builtin_amdgcn_ds_bpermute((lane ^ mask) << 2, __float_as_int(v))); }
DI float wave_sum(float v, int lane) {
#pragma unroll
    for (int o = 1; o < 64; o <<= 1) v += shx(v, o, lane);
    return v;
}
DI int opaque_tid(int wave_s) { int t; asm volatile("v_mbcnt_lo_u32_b32 %0, -1, 0\n\tv_mbcnt_hi_u32_b32 %0, -1, %0" : "=v"(t)); return wave_s * 64 + t; }
#define LDS_WAIT() asm volatile("s_waitcnt lgkmcnt(0)" ::: "memory")

struct Params { const void* in[22]; float* out; unsigned char* ws; };

DI void phase_mod(const float* c, const float* w_ada, const float* b_ada, float* mod, unsigned char* lds, int wave_s) {
    float* cact = (float*)lds;
    float* red = (float*)(lds + 65536);
    const int tid = opaque_tid(wave_s);
    for (int i = tid; i < NB * DM; i += 512) { const float v = c[i]; cact[i] = v / (1.f + __expf(-v)); }
    __syncthreads();
    for (int it = blockIdx.x; it < 384; it += gridDim.x) {
        const int l = it / 192, e0 = (it % 192) * 32, col = tid & 31, kg = tid >> 5;
        const float* w = w_ada + (size_t)l * DM * 6144 + e0 + col;
        float acc[16];
#pragma unroll
        for (int b = 0; b < 16; ++b) acc[b] = 0.f;
#pragma unroll 4
        for (int kk = 0; kk < 64; ++kk) { const int k = kg * 64 + kk; const float wv = w[(size_t)k * 6144];
#pragma unroll
            for (int b = 0; b < 16; ++b) acc[b] += cact[b * DM + k] * wv; }
#pragma unroll
        for (int b = 0; b < 16; ++b) red[(kg * 16 + b) * 32 + col] = acc[b];
        __syncthreads();
        { const int b = tid >> 5; float s = b_ada[l * 6144 + e0 + col];
#pragma unroll
          for (int g = 0; g < 16; ++g) s += red[(g * 16 + b) * 32 + col];
          mod[(size_t)(l * 16 + b) * 6144 + e0 + col] = s; }
        __syncthreads();
    }
}

DI int sigma_col(int mode, int n) {
    if (mode == 1) { const int t = n >> 8; if (t <= 3 || t == 9 || t == 10) { const int c = n & 63; return (n & ~63) + 32 * ((c >> 2) & 1) + 4 * (c >> 3) + (c & 3); } return n; }
    if (mode == 2) { return ((n >> 7) & 1) * DFF + 128 * (n >> 8) + (n & 127); }
    return n;
}
DI void transpose_item(const float* W, int ld, int K, bf16_t* WT, int mode, float* scr, int item, int nblk, int lane) {
    const int kb = item / nblk, nb = item % nblk, k0 = 64 * kb, n0 = 32 * nb;
    const int src = sigma_col(mode, n0 + (lane & 31));
#pragma unroll 8
    for (int i = 0; i < 32; ++i) { const int kk = 2 * i + (lane >> 5); scr[kk * 33 + (lane & 31)] = W[(size_t)(k0 + kk) * ld + src]; }
    LDS_WAIT(); asm volatile("" ::: "memory");
    const int c = lane & 7;
#pragma unroll
    for (int j = 0; j < 4; ++j) { const int n = (lane >> 3) + 8 * j; const float* s = scr + (8 * c) * 33 + n;
        u32x4 o; o.x = pk2(s[0 * 33], s[1 * 33]); o.y = pk2(s[2 * 33], s[3 * 33]); o.z = pk2(s[4 * 33], s[5 * 33]); o.w = pk2(s[6 * 33], s[7 * 33]);
        *(u32x4*)(WT + (size_t)(n0 + n) * K + k0 + 8 * c) = o; }
    LDS_WAIT(); asm volatile("" ::: "memory");
}
template <class PP> DI void phase_conv(PP p, int l, unsigned char* lds, int wave_s) {
    const int tid = opaque_tid(wave_s), lane = tid & 63, wave = tid >> 6;
    float* scr = (float*)(lds + wave * 16384);
    const int gw = blockIdx.x * 8 + wave, NGW = gridDim.x * 8;
    unsigned char* ws = p->ws;
    const float* w_in = (const float*)p->in[7] + (size_t)l * DM * DIN;
    const float* w_a = (const float*)p->in[14] + (size_t)l * 512 * DM;
    const float* w_b = (const float*)p->in[15] + (size_t)l * 256 * DM;
    const float* w_c = (const float*)p->in[16] + (size_t)l * 256 * DM;
    const float* w_o = (const float*)p->in[17] + (size_t)l * DM * DM;
    const float* w_gu = (const float*)p->in[20] + (size_t)l * DM * NGU;
    const float* w_dn = (const float*)p->in[21] + (size_t)l * DFF * DM;
    constexpr int I1 = 16 * 192, I2 = 8 * 32, I3 = 4 * 32, I4 = 4 * 32, I5 = 16 * 32, I6 = 16 * 176, I7 = 44 * 32;
    constexpr int NIT = I1 + I2 + I3 + I4 + I5 + I6 + I7;
    for (int it = gw; it < NIT; it += NGW) {
        int r = it;
        if (r < I1) { transpose_item(w_in, DIN, DM, (bf16_t*)(ws + WS_WIN), 1, scr, r, 192, lane); continue; } r -= I1;
        if (r < I2) { transpose_item(w_a, DM, DM, (bf16_t*)(ws + WS_WBA), 0, scr, r, 32, lane); continue; } r -= I2;
        if (r < I3) { transpose_item(w_b, DM, DM, (bf16_t*)(ws + WS_WBA) + 512, 0, scr, r, 32, lane); continue; } r -= I3;
        if (r < I4) { transpose_item(w_c, DM, DM, (bf16_t*)(ws + WS_WBA) + 768, 0, scr, r, 32, lane); continue; } r -= I4;
        if (r < I5) { transpose_item(w_o, DM, DM, (bf16_t*)(ws + WS_WOUT), 0, scr, r, 32, lane); continue; } r -= I5;
        if (r < I6) { transpose_item(w_gu, NGU, DM, (bf16_t*)(ws + WS_WGU), 2, scr, r, 176, lane); continue; } r -= I6;
        transpose_item(w_dn, DM, DFF, (bf16_t*)(ws + WS_WDN), 0, scr, r, 32, lane);
    }
}

struct RowArgs {
    const float* xsrc; const bf16_t* y; const float* gpost; const float* gt;
    const bf16_t* y2; const float* gpost2; const float* gt2;
    float* xdst;
    const float* gpre; const float* sc; const float* sh; bf16_t* hdst;
#ifdef PROBE_CLASS
    float probe_eps;
#endif
    const float* wfgt; const float* bfgt; float* logf;
};
DI void phase_rows(const RowArgs& a, unsigned char* lds, int wave_s) {
    const int tid = opaque_tid(wave_s), lane = tid & 63, wave = tid >> 6;
    float* wf = (float*)lds;
    if (a.wfgt) {
        for (int i = tid; i < DM * 4; i += 512) wf[i] = a.wfgt[(size_t)(i >> 2) * DIN + (i & 3)];
        __syncthreads();
    }
    const int gw = blockIdx.x * 8 + wave, NGW = gridDim.x * 8;
    for (int chunk = gw; chunk < MT / 16; chunk += NGW) {
        const int m0 = chunk * 16, b = m0 >> 11;
        f32x4 Bm[4], C[4];
#pragma unroll
        for (int j = 0; j < 4; ++j) { const int col = 4 * lane + 256 * j;
            if (a.hdst) { Bm[j] = *(const f32x4*)(a.gpre + col) * (*(const f32x4*)(a.sc + (size_t)b * 6144 + col) + 1.0f); C[j] = *(const f32x4*)(a.sh + (size_t)b * 6144 + col); } }
#pragma unroll 1
        for (int r0 = 0; r0 < 16; r0 += 4) {
            f32x4 x[4][4]; u32x2 yw[4][4];
            const size_t roff = (size_t)(m0 + r0) * DM + 4 * lane;
            const float* xb = a.xsrc + roff; const bf16_t* yb = a.y + roff; const bf16_t* y2b = a.y2 + roff; float* xo = a.xdst + roff; bf16_t* ho = a.hdst + roff;
            asm volatile("" : "+v"(xb), "+v"(yb), "+v"(y2b), "+v"(xo), "+v"(ho));
#pragma unroll
            for (int q = 0; q < 4; ++q)
#pragma unroll
                for (int j = 0; j < 4; ++j) { const int off = q * DM + 256 * j;
                    x[q][j] = __builtin_nontemporal_load((const f32x4*)(xb + off));
                    if (a.y) yw[q][j] = __builtin_nontemporal_load((const u32x2*)(yb + off)); }
            if (a.y) {
                float ss[4];
#pragma unroll
                for (int q = 0; q < 4; ++q) { ss[q] = 0.f;
#pragma unroll
                    for (int j = 0; j < 4; ++j) { const float y0 = bflo(yw[q][j].x), y1 = bfhi(yw[q][j].x), y2 = bflo(yw[q][j].y), y3 = bfhi(yw[q][j].y); ss[q] += (y0 * y0 + y1 * y1) + (y2 * y2 + y3 * y3); } }
#pragma unroll
                for (int o = 1; o < 64; o <<= 1)
#pragma unroll
                    for (int q = 0; q < 4; ++q) ss[q] += shx(ss[q], o, lane);
                f32x4 A[4];
#pragma unroll
                for (int j = 0; j < 4; ++j) { const int col = 4 * lane + 256 * j; A[j] = *(const f32x4*)(a.gpost + col) * *(const f32x4*)(a.gt + (size_t)b * 6144 + col); }
#pragma unroll
                for (int q = 0; q < 4; ++q) { const float rstd = rsqrtf(ss[q] * (1.f / DM) + RMS_EPS);
#pragma unroll
                    for (int j = 0; j < 4; ++j) { const f32x4 yv = (f32x4){bflo(yw[q][j].x), bfhi(yw[q][j].x), bflo(yw[q][j].y), bfhi(yw[q][j].y)}; x[q][j] = x[q][j] + A[j] * (yv * rstd); } }
            }
            if (a.y2) {
                u32x2 zw[4][4];
#pragma unroll
                for (int q = 0; q < 4; ++q)
#pragma unroll
                    for (int j = 0; j < 4; ++j) zw[q][j] = __builtin_nontemporal_load((const u32x2*)(y2b + q * DM + 256 * j));
                float ss[4];
#pragma unroll
                for (int q = 0; q < 4; ++q) { ss[q] = 0.f;
#pragma unroll
                    for (int j = 0; j < 4; ++j) { const float y0 = bflo(zw[q][j].x), y1 = bfhi(zw[q][j].x), y2v = bflo(zw[q][j].y), y3 = bfhi(zw[q][j].y); ss[q] += (y0 * y0 + y1 * y1) + (y2v * y2v + y3 * y3); } }
#pragma unroll
                for (int o = 1; o < 64; o <<= 1)
#pragma unroll
                    for (int q = 0; q < 4; ++q) ss[q] += shx(ss[q], o, lane);
                f32x4 A2[4];
#pragma unroll
                for (int j = 0; j < 4; ++j) { const int col = 4 * lane + 256 * j; A2[j] = *(const f32x4*)(a.gpost2 + col) * *(const f32x4*)(a.gt2 + (size_t)b * 6144 + col); }
#pragma unroll
                for (int q = 0; q < 4; ++q) { const float rstd = rsqrtf(ss[q] * (1.f / DM) + RMS_EPS);
#pragma unroll
                    for (int j = 0; j < 4; ++j) { const f32x4 yv = (f32x4){bflo(zw[q][j].x), bfhi(zw[q][j].x), bflo(zw[q][j].y), bfhi(zw[q][j].y)}; x[q][j] = x[q][j] + A2[j] * (yv * rstd); } }
            }
            if (a.xdst) {
#ifdef PROBE_CLASS
                if (a.probe_eps != 0.f && r0 == 0) {
#pragma unroll
                    for (int j = 0; j < 4; ++j) x[0][j] = x[0][j] * (1.f + a.probe_eps); }
#endif
#pragma unroll
                for (int q = 0; q < 4; ++q)
#pragma unroll
                    for (int j = 0; j < 4; ++j) __builtin_nontemporal_store(x[q][j], (f32x4*)(xo + q * DM + 256 * j));
            }
            if (a.hdst) {
                float ss[4];
#pragma unroll
                for (int q = 0; q < 4; ++q) { ss[q] = 0.f;
#pragma unroll
                    for (int j = 0; j < 4; ++j) ss[q] += (x[q][j].x * x[q][j].x + x[q][j].y * x[q][j].y) + (x[q][j].z * x[q][j].z + x[q][j].w * x[q][j].w); }
#pragma unroll
                for (int o = 1; o < 64; o <<= 1)
#pragma unroll
                    for (int q = 0; q < 4; ++q) ss[q] += shx(ss[q], o, lane);
                float lg[4][4];
#pragma unroll
                for (int q = 0; q < 4; ++q) { const float rstd = rsqrtf(ss[q] * (1.f / DM) + RMS_EPS);
                    lg[q][0] = 0.f; lg[q][1] = 0.f; lg[q][2] = 0.f; lg[q][3] = 0.f;
#pragma unroll
                    for (int j = 0; j < 4; ++j) { const int col = 4 * lane + 256 * j;
                        const f32x4 hv = x[q][j] * rstd * Bm[j] + C[j];
                        u32x2 o; o.x = pk2(hv.x, hv.y); o.y = pk2(hv.z, hv.w);
                        *(u32x2*)(ho + q * DM + 256 * j) = o;
                        if (a.wfgt) {
#pragma unroll
                            for (int e = 0; e < 4; ++e) { const f32x4 w4 = *(const f32x4*)(wf + (col + e) * 4); const float hh = hv[e];
                                lg[q][0] += hh * w4.x; lg[q][1] += hh * w4.y; lg[q][2] += hh * w4.z; lg[q][3] += hh * w4.w; } } } }
                if (a.wfgt) {
#pragma unroll
                    for (int o = 1; o < 64; o <<= 1)
#pragma unroll
                        for (int q = 0; q < 4; ++q)
#pragma unroll
                            for (int e = 0; e < 4; ++e) lg[q][e] += shx(lg[q][e], o, lane);
                    if (lane < 16) { const int q = lane >> 2, e = lane & 3; float z = 0.f;
#pragma unroll
                        for (int qq = 0; qq < 4; ++qq)
#pragma unroll
                            for (int ee = 0; ee < 4; ++ee) z = (q == qq && e == ee) ? lg[qq][ee] : z;
                        z += a.bfgt[e];
                        const float lf = fminf(z, 0.f) - __logf(1.f + __expf(-fabsf(z)));
                        a.logf[(size_t)(b * 4 + e) * SEQ + ((m0 + r0 + q) & (SEQ - 1))] = lf; }
                }
            }
        }
    }
}
struct EpiIn {
    static constexpr bool PERM = true, AFTER_DRAIN = false, KHOOK = false;
    bf16_t* qkv; bf16_t* gate; const int* pos;
    DI void operator()(const f32x4 (&acc)[2][2][4][2], const pg8::Unit& u, int wr, int wc, int fr, int fq) const {
        const int pn = u.pn, row0 = u.pm * 256 + wr * 64 + fr;
        if (pn >= 12) {
            const int col0 = (pn - 12) * 256 + wc * 32 + 8 * fq;
#pragma unroll
            for (int ai = 0; ai < 2; ++ai)
#pragma unroll
                for (int m = 0; m < 4; ++m) { bf16_t* rowp = gate + (size_t)(row0 + ai * 128 + m * 16) * 3072 + col0;
#pragma unroll
                    for (int bj = 0; bj < 2; ++bj) { const f32x4 v0 = acc[ai][bj][m][0], v1 = acc[ai][bj][m][1]; float s[8];
#pragma unroll
                        for (int e = 0; e < 4; ++e) { s[e] = 1.f / (1.f + __expf(-v0[e])); s[4 + e] = 1.f / (1.f + __expf(-v1[e])); }
                        u32x4 w; w.x = pk2(s[0], s[1]); w.y = pk2(s[2], s[3]); w.z = pk2(s[4], s[5]); w.w = pk2(s[6], s[7]);
                        __builtin_nontemporal_store(w, (u32x4*)(rowp + bj * 128)); } }
        } else if (pn == 4 || pn == 5 || pn == 8 || pn == 11) {
            const bool wide = (pn <= 5);
            const size_t toff = wide ? VA_OFF : (pn == 8 ? VB_OFF : VC_OFF);
            const int DV = wide ? 128 : 64;
            const int b = u.pm >> 3, sbase = (u.pm & 7) * 256 + wr * 64;
            const int hh = (fr >> 2) & 1, j = ((fr >> 3) << 2) | (fr & 3);
#pragma unroll
            for (int bj = 0; bj < 2; ++bj) {
                const int head = wide ? (2 * (pn - 4) + bj) : (2 * bj + (wc >> 1));
                const int dbase = wide ? (32 * wc + 8 * fq) : (32 * (wc & 1) + 8 * fq);
                const int bh = b * 4 + head;
#pragma unroll
                for (int ai = 0; ai < 2; ++ai)
#pragma unroll
                    for (int m = 0; m < 4; ++m) { const int s = sbase + ai * 128 + m * 16, tile = s >> 5, st = m & 1;
                        bf16_t* bp = qkv + toff + ((size_t)(((bh * 64 + tile) * 2 + st) * 2 + hh) * DV + dbase) * 8 + j;
#pragma unroll
                        for (int n = 0; n < 2; ++n) { const f32x4 v = acc[ai][bj][m][n];
                            const unsigned w0 = pk2(v[0], v[1]), w1 = pk2(v[2], v[3]);
                            bp[(4 * n + 0) * 8] = (bf16_t)(w0 & 0xffffu); bp[(4 * n + 1) * 8] = (bf16_t)(w0 >> 16);
                            bp[(4 * n + 2) * 8] = (bf16_t)(w1 & 0xffffu); bp[(4 * n + 3) * 8] = (bf16_t)(w1 >> 16); } }
            }
        } else {
            const bool rope = !(pn == 6 || pn == 7);
            size_t toff; int NH, hbase;
            if (pn <= 1) { toff = QA_OFF; NH = 8; hbase = 4 * (pn & 1); }
            else if (pn <= 3) { toff = KA_OFF; NH = 8; hbase = 4 * (pn & 1); }
            else if (pn == 6) { toff = QB_OFF; NH = 4; hbase = 0; }
            else if (pn == 7) { toff = KB_OFF; NH = 4; hbase = 0; }
            else if (pn == 9) { toff = QC_OFF; NH = 4; hbase = 0; }
            else { toff = KC_OFF; NH = 4; hbase = 0; }
            const int b = u.pm >> 3, sbase = (u.pm & 7) * 256 + wr * 64 + fr;
            const int c0 = 32 * (wc & 1) + 8 * fq;
            float invf[4];
#pragma unroll
            for (int e = 0; e < 4; ++e) invf[e] = __builtin_amdgcn_exp2f(-(float)(16 * (wc & 1) + 4 * fq + e) * (13.287712379549449f / 32.0f));
#pragma unroll
            for (int ai = 0; ai < 2; ++ai)
#pragma unroll
                for (int m = 0; m < 4; ++m) { const int s = sbase + ai * 128 + m * 16;
                    float cs[4], sn[4];
                    if (rope) { const float pf = (float)pos[b * SEQ + s];
#pragma unroll
                        for (int e = 0; e < 4; ++e) { float t = (pf * invf[e]) * 0.15915494309189535f; t = t - floorf(t); sn[e] = __builtin_amdgcn_sinf(t); cs[e] = __builtin_amdgcn_cosf(t); } }
                    else {
#pragma unroll
                        for (int e = 0; e < 4; ++e) { cs[e] = 1.f; sn[e] = 0.f; } }
#pragma unroll
                    for (int bj = 0; bj < 2; ++bj) { const int head = hbase + 2 * bj + (wc >> 1);
                        const f32x4 x1 = acc[ai][bj][m][0], x2 = acc[ai][bj][m][1]; float o1[4], o2[4];
#pragma unroll
                        for (int e = 0; e < 4; ++e) { o1[e] = x1[e] * cs[e] - x2[e] * sn[e]; o2[e] = x2[e] * cs[e] + x1[e] * sn[e]; }
                        u32x4 w; w.x = pk2(o1[0], o1[1]); w.y = pk2(o1[2], o1[3]); w.z = pk2(o2[0], o2[1]); w.w = pk2(o2[2], o2[3]);
                        *(u32x4*)(qkv + toff + ((size_t)((b * NH + head) * SEQ + s)) * 64 + c0) = w; } }
        }
    }
};
template <int PASS> struct EpiMerge {
    static constexpr bool PERM = true, AFTER_DRAIN = false, KHOOK = false;
    const bf16_t* gate; bf16_t* merged;
    DI void operator()(const f32x4 (&acc)[2][2][4][2], const pg8::Unit& u, int wr, int wc, int fr, int fq) const {
        const int row0 = u.pm * 256 + wr * 64 + fr, col0 = u.pn * 256 + wc * 32 + 8 * fq;
#pragma unroll
        for (int ai = 0; ai < 2; ++ai)
#pragma unroll
            for (int m = 0; m < 4; ++m) { const size_t row = (size_t)(row0 + ai * 128 + m * 16);
#pragma unroll
                for (int bj = 0; bj < 2; ++bj) { const int col = col0 + bj * 128;
                    const u32x4 g = *(const u32x4*)(gate + row * 3072 + PASS * 1024 + col);
                    f32x4 v0 = acc[ai][bj][m][0] * (f32x4){bflo(g.x), bfhi(g.x), bflo(g.y), bfhi(g.y)};
                    f32x4 v1 = acc[ai][bj][m][1] * (f32x4){bflo(g.z), bfhi(g.z), bflo(g.w), bfhi(g.w)};
                    bf16_t* mp = merged + row * DM + col;
                    if (PASS > 0) { const u32x4 pv = *(const u32x4*)mp; v0 = v0 + (f32x4){bflo(pv.x), bfhi(pv.x), bflo(pv.y), bfhi(pv.y)}; v1 = v1 + (f32x4){bflo(pv.z), bfhi(pv.z), bflo(pv.w), bfhi(pv.w)}; }
                    u32x4 w; w.x = pk2(v0[0], v0[1]); w.y = pk2(v0[2], v0[3]); w.z = pk2(v1[0], v1[1]); w.w = pk2(v1[2], v1[3]);
                    *(u32x4*)mp = w; } }
    }
};
struct EpiMergeK {
    static constexpr bool PERM = true, AFTER_DRAIN = false, KHOOK = true;
    const bf16_t* gate; bf16_t* merged;
    static DI f32x4 lo4(const u32x4 g) { return (f32x4){bflo(g.x), bfhi(g.x), bflo(g.y), bfhi(g.y)}; }
    static DI f32x4 hi4(const u32x4 g) { return (f32x4){bflo(g.z), bfhi(g.z), bflo(g.w), bfhi(g.w)}; }
    static DI f32x4 clampg(f32x4 v) { return (f32x4){fmaxf(v[0], 1e-18f), fmaxf(v[1], 1e-18f), fmaxf(v[2], 1e-18f), fmaxf(v[3], 1e-18f)}; }
    static DI f32x4 rcp4(f32x4 v) { return (f32x4){__builtin_amdgcn_rcpf(v[0]), __builtin_amdgcn_rcpf(v[1]), __builtin_amdgcn_rcpf(v[2]), __builtin_amdgcn_rcpf(v[3])}; }
    DI void khook(f32x4 (&acc)[2][2][4][2], const pg8::Unit& u, int t, int wr, int wc, int fr, int fq) const {
        if (t != 8 && t != 12) return;
        const bf16_t* gp0 = gate + (size_t)(u.pm * 256 + wr * 64 + fr) * 3072 + (t == 8 ? 0 : 1024) + u.pn * 256 + wc * 32 + 8 * fq;
        asm volatile("" : "+v"(gp0));
        u32x4 dummy = {0u, 0u, 0u, 0u};
#define PF_LD(P, OFF) asm volatile("global_load_dwordx4 %0, %1, off offset:" #OFF : "+v"(dummy) : "v"(P) : "memory")
        if (t == 8) {
#pragma unroll
        for (int ai = 0; ai < 2; ++ai)
#pragma unroll
            for (int m = 0; m < 4; ++m) { const bf16_t* pp = gp0 + 2048 + (size_t)(ai * 128 + m * 16) * 3072; PF_LD(pp, 0); PF_LD(pp, 256); }
        }
#undef PF_LD
#pragma unroll
        for (int ai = 0; ai < 2; ++ai)
            {
                u32x4 gn[4][2], gd[4][2];
#pragma unroll
                for (int m = 0; m < 4; ++m)
#pragma unroll
                    for (int bj = 0; bj < 2; ++bj) { const bf16_t* gp = gp0 + (size_t)(ai * 128 + m * 16) * 3072 + bj * 128; gn[m][bj] = *(const u32x4*)gp; gd[m][bj] = *(const u32x4*)(gp + 1024); }
#pragma unroll
                for (int m = 0; m < 4; ++m)
#pragma unroll
                    for (int bj = 0; bj < 2; ++bj) {
                        acc[ai][bj][m][0] = acc[ai][bj][m][0] * (clampg(lo4(gn[m][bj])) * rcp4(clampg(lo4(gd[m][bj]))));
                        acc[ai][bj][m][1] = acc[ai][bj][m][1] * (clampg(hi4(gn[m][bj])) * rcp4(clampg(hi4(gd[m][bj])))); }
                asm volatile("" : "+v"(acc[ai][0][0][0]), "+v"(acc[ai][0][0][1]), "+v"(acc[ai][1][0][0]), "+v"(acc[ai][1][0][1]), "+v"(acc[ai][0][1][0]), "+v"(acc[ai][0][1][1]), "+v"(acc[ai][1][1][0]), "+v"(acc[ai][1][1][1]),
                             "+v"(acc[ai][0][2][0]), "+v"(acc[ai][0][2][1]), "+v"(acc[ai][1][2][0]), "+v"(acc[ai][1][2][1]), "+v"(acc[ai][0][3][0]), "+v"(acc[ai][0][3][1]), "+v"(acc[ai][1][3][0]), "+v"(acc[ai][1][3][1]) :: "memory"); }
        asm volatile("s_waitcnt vmcnt(0)" : "+v"(dummy) :: "memory");
    }
    DI void operator()(const f32x4 (&acc)[2][2][4][2], const pg8::Unit& u, int wr, int wc, int fr, int fq) const {
        const int row0 = u.pm * 256 + wr * 64 + fr, col0 = u.pn * 256 + wc * 32 + 8 * fq;
#pragma unroll
        for (int ai = 0; ai < 2; ++ai)
#pragma unroll
            for (int m = 0; m < 4; ++m) { const size_t row = (size_t)(row0 + ai * 128 + m * 16);
#pragma unroll
                for (int bj = 0; bj < 2; ++bj) { const int col = col0 + bj * 128;
                    const u32x4 g = *(const u32x4*)(gate + row * 3072 + 2 * 1024 + col);
                    const f32x4 v0 = acc[ai][bj][m][0] * clampg(lo4(g)), v1 = acc[ai][bj][m][1] * clampg(hi4(g));
                    u32x4 w; w.x = pk2(v0[0], v0[1]); w.y = pk2(v0[2], v0[3]); w.z = pk2(v1[0], v1[1]); w.w = pk2(v1[2], v1[3]);
                    *(u32x4*)(merged + row * DM + col) = w; } }
    }
};
struct EpiPlain {
    static constexpr bool PERM = true, AFTER_DRAIN = false, KHOOK = false;
    bf16_t* O; int ldc;
    DI void operator()(const f32x4 (&acc)[2][2][4][2], const pg8::Unit& u, int wr, int wc, int fr, int fq) const {
        const int row0 = u.pm * 256 + wr * 64 + fr, col0 = u.pn * 256 + wc * 32 + 8 * fq;
#pragma unroll
        for (int ai = 0; ai < 2; ++ai)
#pragma unroll
            for (int m = 0; m < 4; ++m) { bf16_t* rowp = O + (size_t)(row0 + ai * 128 + m * 16) * ldc + col0;
#pragma unroll
                for (int bj = 0; bj < 2; ++bj) { const f32x4 v0 = acc[ai][bj][m][0], v1 = acc[ai][bj][m][1];
                    u32x4 w; w.x = pk2(v0[0], v0[1]); w.y = pk2(v0[2], v0[3]); w.z = pk2(v1[0], v1[1]); w.w = pk2(v1[2], v1[3]);
                    *(u32x4*)(rowp + bj * 128) = w; } }
    }
};
struct EpiSwiglu {
    static constexpr bool PERM = true, AFTER_DRAIN = false, KHOOK = false;
    bf16_t* act;
    DI void operator()(const f32x4 (&acc)[2][2][4][2], const pg8::Unit& u, int wr, int wc, int fr, int fq) const {
        const int row0 = u.pm * 256 + wr * 64 + fr, col0 = u.pn * 128 + wc * 32 + 8 * fq;
#pragma unroll
        for (int ai = 0; ai < 2; ++ai)
#pragma unroll
            for (int m = 0; m < 4; ++m) { bf16_t* rowp = act + (size_t)(row0 + ai * 128 + m * 16) * DFF + col0;
                float r[8];
#pragma unroll
                for (int n = 0; n < 2; ++n) { const f32x4 a = acc[ai][0][m][n], bv = acc[ai][1][m][n];
#pragma unroll
                    for (int e = 0; e < 4; ++e) r[4 * n + e] = a[e] / (1.f + __expf(-a[e])) * bv[e]; }
                u32x4 w; w.x = pk2(r[0], r[1]); w.y = pk2(r[2], r[3]); w.z = pk2(r[4], r[5]); w.w = pk2(r[6], r[7]);
                __builtin_nontemporal_store(w, (u32x4*)rowp); }
    }
};

DI void phase_mini(const float* logf, float* cum, const bf16_t* kc, float* kmean, unsigned* ctl, const bf16_t* kbf, unsigned* kmax, int wave_s) {
    const int tid = opaque_tid(wave_s), lane = tid & 63, wave = tid >> 6;
    if (blockIdx.x == 0 && tid == 0) ctl[0] = 0u;
    const int gw = blockIdx.x * 8 + wave, NGW = gridDim.x * 8;
    for (int it = gw; it < 64 + 512 + 512; it += NGW) {
        if (it >= 64 + 512) {
            const int idx = it - 576, bh = idx >> 3, n = idx & 7;
            const bf16_t* kp = kbf + ((size_t)bh * SEQ + n * 256 + (lane >> 3)) * 64 + 8 * (lane & 7);
            float mxn = 0.f;
#pragma unroll 4
            for (int i = 0; i < 32; ++i) { const u32x4 w = *(const u32x4*)(kp + (size_t)(8 * i) * 64);
                float s = bflo(w.x) * bflo(w.x) + bfhi(w.x) * bfhi(w.x) + bflo(w.y) * bflo(w.y) + bfhi(w.y) * bfhi(w.y) + bflo(w.z) * bflo(w.z) + bfhi(w.z) * bfhi(w.z) + bflo(w.w) * bflo(w.w) + bfhi(w.w) * bfhi(w.w);
                s += shx(s, 1, lane); s += shx(s, 2, lane); s += shx(s, 4, lane);
                mxn = fmaxf(mxn, s); }
#pragma unroll
            for (int o = 8; o < 64; o <<= 1) mxn = fmaxf(mxn, shx(mxn, o, lane));
            if (lane == 0) atomicMax(kmax + bh, __float_as_uint(mxn));
            continue;
        }
        if (it < 64) {
            const float* src = logf + (size_t)it * SEQ + lane * 32; float* dst = cum + (size_t)it * SEQ + lane * 32;
            f32x4 v[8]; float run = 0.f;
#pragma unroll
            for (int j = 0; j < 8; ++j) { v[j] = *(const f32x4*)(src + 4 * j); v[j].x += run; v[j].y += v[j].x; v[j].z += v[j].y; v[j].w += v[j].z; run = v[j].w; }
            float incl = run;
#pragma unroll
            for (int o = 1; o < 64; o <<= 1) { const int srcl = lane >= o ? lane - o : lane; const float t = __int_as_float(__builtin_amdgcn_ds_bpermute(srcl << 2, __float_as_int(incl))); if (lane >= o) incl += t; }
            const float excl = incl - run;
#pragma unroll
            for (int j = 0; j < 8; ++j) *(f32x4*)(dst + 4 * j) = (v[j] + excl) * LOG2E;
        } else {
            const int idx = it - 64, bh = idx >> 3, n = idx & 7;
            const bf16_t* kp = kc + ((size_t)bh * SEQ + n * 256 + (lane >> 3)) * 64 + 8 * (lane & 7);
            float s[8];
#pragma unroll
            for (int e = 0; e < 8; ++e) s[e] = 0.f;
#pragma unroll 8
            for (int i = 0; i < 32; ++i) { const u32x4 w = *(const u32x4*)(kp + (size_t)(8 * i) * 64);
                s[0] += bflo(w.x); s[1] += bfhi(w.x); s[2] += bflo(w.y); s[3] += bfhi(w.y); s[4] += bflo(w.z); s[5] += bfhi(w.z); s[6] += bflo(w.w); s[7] += bfhi(w.w); }
#pragma unroll
            for (int o = 8; o < 64; o <<= 1)
#pragma unroll
                for (int e = 0; e < 8; ++e) s[e] += shx(s[e], o, lane);
            if (lane < 8) {
                float* kd = kmean + (size_t)idx * 64 + 8 * lane;
                *(f32x4*)kd = (f32x4){s[0], s[1], s[2], s[3]} * (1.f / 256.f); *(f32x4*)(kd + 4) = (f32x4){s[4], s[5], s[6], s[7]} * (1.f / 256.f); }
        }
    }
}

#define MFMA32(a, b, c) __builtin_amdgcn_mfma_f32_32x32x16_bf16((a), (b), (c), 0, 0, 0)
DI float xmax32(float v) { const auto r = __builtin_amdgcn_permlane32_swap(__float_as_uint(v), __float_as_uint(v), false, false); return fmaxf(__uint_as_float(r[0]), __uint_as_float(r[1])); }
DI float xsum32(float v) { const auto r = __builtin_amdgcn_permlane32_swap(__float_as_uint(v), __float_as_uint(v), false, false); return __uint_as_float(r[0]) + __uint_as_float(r[1]); }
constexpr int AT_KV = 65536, AT_KB = 9216;
#define ABAR() do { asm volatile("s_waitcnt lgkmcnt(0)" ::: "memory"); __builtin_amdgcn_s_barrier(); asm volatile("" ::: "memory"); } while (0)
template <int DT, int MODE>
DI void attn_stream(const bf16_t* __restrict__ Qh, const bf16_t* __restrict__ Kh, const bf16_t* __restrict__ Vt, const int qb, const int wave, const int lane, const int tid,
                    unsigned char* lds, f32x16 (&O)[DT], float& l_out, const float* __restrict__ cum, const float* __restrict__ kmean, const float kmax2) {
    constexpr int DV = DT * 32;
    const int r = lane & 31, h = lane >> 5;
    const int q0 = qb * 256 + wave * 32;
    const float SCL = 0.125f * LOG2E;
    bf16x8 qf[4];
#pragma unroll
    for (int c = 0; c < 4; ++c) qf[c] = *(const bf16x8*)(Qh + (size_t)(q0 + r) * 64 + h * 32 + c * 8);
    const int last = q0 >> 6, own = qb, wg_last = 4 * qb + 3;
    unsigned sel = 0u, anysel = 0u, wg_any = 0u;
    if (MODE == 2) {
        if (own <= 3) sel = (1u << own) - 1u;
        else {
            float g[7];
#pragma unroll
            for (int n = 0; n < 7; ++n) {
                float part = 0.f;
                if (n < own) {
#pragma unroll
                    for (int c = 0; c < 4; ++c) { const float* kmp = kmean + n * 64 + h * 32 + c * 8; const f32x4 k0 = *(const f32x4*)kmp, k1 = *(const f32x4*)(kmp + 4);
                        const u32x4 qw = __builtin_bit_cast(u32x4, qf[c]);
                        part += bflo(qw.x) * k0.x + bfhi(qw.x) * k0.y + bflo(qw.y) * k0.z + bfhi(qw.y) * k0.w + bflo(qw.z) * k1.x + bfhi(qw.z) * k1.y + bflo(qw.w) * k1.z + bfhi(qw.w) * k1.w; }
                    part += shx(part, 32, lane);
                } else part = -3.0e38f;
                g[n] = part;
            }
#pragma unroll
            for (int t = 0; t < 3; ++t) { float bv = -3.4e38f; int best = 0;
#pragma unroll
                for (int n = 0; n < 7; ++n) { const bool ok = (n < own) && !((sel >> n) & 1u) && (g[n] > bv); bv = ok ? g[n] : bv; best = ok ? n : best; }
                sel |= 1u << best; }
        }
        const unsigned long long b0 = __ballot((sel >> 0) & 1u), b1 = __ballot((sel >> 1) & 1u), b2 = __ballot((sel >> 2) & 1u), b3 = __ballot((sel >> 3) & 1u),
                                 b4 = __ballot((sel >> 4) & 1u), b5 = __ballot((sel >> 5) & 1u), b6 = __ballot((sel >> 6) & 1u);
        anysel = (b0 ? 1u : 0u) | (b1 ? 2u : 0u) | (b2 ? 4u : 0u) | (b3 ? 8u : 0u) | (b4 ? 16u : 0u) | (b5 ? 32u : 0u) | (b6 ? 64u : 0u);
        volatile unsigned* aw = (volatile unsigned*)(lds + LDS_MISC + 128);
        if (lane == 0) aw[wave] = anysel;
        __syncthreads();
#pragma unroll
        for (int w = 0; w < 8; ++w) wg_any |= aw[w];
    }
    float cql = 0.f;
    if (MODE == 1) cql = cum[q0 + r];
    float m_run = -1.0e30f, l_run = 0.f;
#pragma unroll
    for (int dt = 0; dt < DT; ++dt)
#pragma unroll
        for (int i = 0; i < 16; ++i) O[dt][i] = 0.f;

    auto nxt = [&](int kt) -> int {
        int k = kt + 1;
        if (MODE == 2) { while (k < own * 4 && !((wg_any >> (k >> 2)) & 1u)) k = ((k >> 2) + 1) * 4; }
        return k;
    };
    constexpr int AT_BUF = AT_KB + DT * 4096;
    const float* cuml = (const float*)(lds + AT_KV + 2 * AT_BUF);
    if (MODE == 1) *(f32x4*)(lds + AT_KV + 2 * AT_BUF + tid * 16) = *(const f32x4*)(cum + tid * 4);
    struct Stage { u32x4 k; u32x4 v[DT / 2]; };
    Stage sA, sB;
    auto gload = [&](int kt_, Stage& s) {
        const int kt = kt_ < 0 ? 0 : (kt_ < wg_last ? kt_ : wg_last);
        s.k = *(const u32x4*)(Kh + (size_t)kt * 4096 + tid * 8);
#pragma unroll
        for (int j = 0; j < DT / 2; ++j) s.v[j] = *(const u32x4*)(Vt + (size_t)kt * 64 * DV + j * 4096 + tid * 8);
    };
    auto lstore = [&](int buf, const Stage& s) {
        unsigned char* bp = lds + AT_KV + buf * AT_BUF;
        *(u32x4*)(bp + (tid >> 3) * 144 + (tid & 7) * 16) = s.k;
#pragma unroll
        for (int j = 0; j < DT / 2; ++j) *(u32x4*)(bp + AT_KB + j * 8192 + tid * 16) = s.v[j];
    };
    auto compute = [&](const int kt, const int cur) {
        const bool mine = (kt <= last) && (MODE != 2 || (kt >> 2) >= own || ((anysel >> (kt >> 2)) & 1u));
        if (mine) {
            const unsigned char* bp = lds + AT_KV + cur * AT_BUF;
            f32x16 S[2];
            {
                bf16x8 kf[2][4];
#pragma unroll
                for (int s2 = 0; s2 < 2; ++s2)
#pragma unroll
                    for (int c = 0; c < 4; ++c) kf[s2][c] = *(const bf16x8*)(bp + (s2 * 32 + r) * 144 + h * 64 + c * 16);
                asm volatile("" : "+v"(kf[0][0]), "+v"(kf[0][1]), "+v"(kf[0][2]), "+v"(kf[0][3]), "+v"(kf[1][0]), "+v"(kf[1][1]), "+v"(kf[1][2]), "+v"(kf[1][3]));
#pragma unroll
                for (int s2 = 0; s2 < 2; ++s2) {
#pragma unroll
                    for (int i = 0; i < 16; ++i) S[s2][i] = 0.f;
#pragma unroll
                    for (int c = 0; c < 4; ++c) S[s2] = MFMA32(kf[s2][c], qf[c], S[s2]);
                }
            }
#ifdef EXP_LDS2X
            {
#pragma unroll
                for (int s2 = 0; s2 < 2; ++s2) {
#pragma unroll
                    for (int c = 0; c < 4; ++c) { bf16x8 d = *(const volatile bf16x8*)(bp + (s2 * 32 + r) * 144 + h * 64 + c * 16); asm volatile("" :: "v"(d)); }
#pragma unroll
                    for (int st = 0; st < 2; ++st)
#pragma unroll
                        for (int dt = 0; dt < DT; ++dt) { bf16x8 d = *(const volatile bf16x8*)(bp + AT_KB + s2 * (DT * 2048) + (((st * 2 + h) * DV) + dt * 32 + r) * 16); asm volatile("" :: "v"(d)); }
                }
            }
#endif
            const bool diag = (kt == last);
            bool rowsel = true, rowmask = false;
            if (MODE == 2) { const int n = kt >> 2; if (n < own) { rowsel = ((sel >> n) & 1u) != 0u; rowmask = true; } }
            float t[2][16];
#pragma unroll
            for (int s2 = 0; s2 < 2; ++s2) {
                if (MODE == 1) {
#pragma unroll
                    for (int g = 0; g < 4; ++g) { const f32x4 ck = *(const f32x4*)(cuml + kt * 64 + s2 * 32 + 8 * g + 4 * h);
#pragma unroll
                        for (int e = 0; e < 4; ++e) t[s2][4 * g + e] = __builtin_fmaf(S[s2][4 * g + e], SCL, cql - ck[e]); }
                } else {
#pragma unroll
                    for (int i = 0; i < 16; ++i) t[s2][i] = S[s2][i];
                }
            }
            if (diag) {
                const int lim = (q0 - kt * 64) + r;
#pragma unroll
                for (int s2 = 0; s2 < 2; ++s2)
#pragma unroll
                    for (int i = 0; i < 16; ++i) { const int kr = s2 * 32 + (i & 3) + 8 * (i >> 2) + 4 * h; t[s2][i] = (kr <= lim) ? t[s2][i] : -1.0e30f; }
            }
            float mx = fmaxf(t[0][0], t[1][0]);
#pragma unroll
            for (int i = 1; i < 16; ++i) mx = fmaxf(mx, fmaxf(t[0][i], t[1][i]));
            mx = xmax32(mx);
            float cand = (MODE == 1) ? mx : mx * SCL;
            if (rowmask) cand = rowsel ? cand : m_run;
            if (__builtin_amdgcn_ballot_w64(cand > m_run + 8.0f) != 0ull) {
                const float m_nw = fmaxf(m_run, cand);
                const float alpha = __builtin_amdgcn_exp2f(m_run - m_nw);
                l_run *= alpha;
#pragma unroll
                for (int dt = 0; dt < DT; ++dt)
#pragma unroll
                    for (int i = 0; i < 16; ++i) O[dt][i] *= alpha;
                m_run = m_nw;
            }
            const float m_new = m_run;
            float p[2][16]; float ls = 0.f;
#pragma unroll
            for (int s2 = 0; s2 < 2; ++s2)
#pragma unroll
                for (int i = 0; i < 16; ++i) p[s2][i] = __builtin_amdgcn_exp2f((MODE == 1) ? (t[s2][i] - m_new) : __builtin_fmaf(t[s2][i], SCL, -m_new));
            if (diag) {
#pragma unroll
                for (int s2 = 0; s2 < 2; ++s2)
#pragma unroll
                    for (int i = 0; i < 16; ++i) p[s2][i] = (t[s2][i] <= -1.0e29f) ? 0.f : p[s2][i];
            }
            if (rowmask) {
#pragma unroll
                for (int s2 = 0; s2 < 2; ++s2)
#pragma unroll
                    for (int i = 0; i < 16; ++i) p[s2][i] = rowsel ? p[s2][i] : 0.f;
            }
#pragma unroll
            for (int i = 0; i < 16; ++i) ls += p[0][i] + p[1][i];
            l_run += ls;
#pragma unroll
            for (int s2 = 0; s2 < 2; ++s2) {
                bf16x8 vf[2][DT];
#pragma unroll
                for (int st = 0; st < 2; ++st)
#pragma unroll
                    for (int dt = 0; dt < DT; ++dt) vf[st][dt] = *(const bf16x8*)(bp + AT_KB + s2 * (DT * 2048) + (((st * 2 + h) * DV) + dt * 32 + r) * 16);
                if constexpr (DT == 4) asm volatile("" : "+v"(vf[0][0]), "+v"(vf[0][1]), "+v"(vf[0][2]), "+v"(vf[0][DT - 1]), "+v"(vf[1][0]), "+v"(vf[1][1]), "+v"(vf[1][2]), "+v"(vf[1][DT - 1]));
                else asm volatile("" : "+v"(vf[0][0]), "+v"(vf[0][1]), "+v"(vf[1][0]), "+v"(vf[1][1]));
#pragma unroll
                for (int st = 0; st < 2; ++st) {
                    u32x4 pw; pw.x = pk2(p[s2][8 * st + 0], p[s2][8 * st + 1]); pw.y = pk2(p[s2][8 * st + 2], p[s2][8 * st + 3]); pw.z = pk2(p[s2][8 * st + 4], p[s2][8 * st + 5]); pw.w = pk2(p[s2][8 * st + 6], p[s2][8 * st + 7]);
                    const bf16x8 pf = __builtin_bit_cast(bf16x8, pw);
#pragma unroll
                    for (int dt = 0; dt < DT; ++dt) O[dt] = MFMA32(vf[st][dt], pf, O[dt]);
                }
            }
        }
    };
    if (MODE == 1) {
        float qn2 = 0.f;
#pragma unroll
        for (int c = 0; c < 4; ++c) { const u32x4 qw = __builtin_bit_cast(u32x4, qf[c]);
            qn2 += bflo(qw.x) * bflo(qw.x) + bfhi(qw.x) * bfhi(qw.x) + bflo(qw.y) * bflo(qw.y) + bfhi(qw.y) * bfhi(qw.y) + bflo(qw.z) * bflo(qw.z) + bfhi(qw.z) * bfhi(qw.z) + bflo(qw.w) * bflo(qw.w) + bfhi(qw.w) * bfhi(qw.w); }
        qn2 += shx(qn2, 32, lane);
        const float qkb = sqrtf(qn2 * kmax2) * SCL * 1.001f + 127.0f;
        volatile unsigned* fl = (volatile unsigned*)(lds + LDS_MISC + 160);
        bool done = false;
        int kt = wg_last, cur = 0, par = 0;
        gload(kt, sA); lstore(0, sA);
        int ka = kt - 1;
        gload(ka, sA);
        asm volatile("" : "+v"(qf[0]), "+v"(qf[1]), "+v"(qf[2]), "+v"(qf[3]), "+v"(cql));
        ABAR();
        auto step_done = [&](const int k) {
            if (!done && k <= last) {
                if (k == 0) done = true;
                else { const float bmax = cql - cuml[k * 64 - 1]; const bool ok = (qkb + bmax) < m_run; done = (__builtin_amdgcn_ballot_w64(!ok) == 0ull); }
            }
        };
        for (;;) {
            const int kb = ka - 1;
            gload(kb, sB);
            if (!done) compute(kt, cur);
            step_done(kt);
            if (lane == 0) fl[par * 8 + wave] = done ? 0u : 1u;
            lstore(cur ^ 1, sA);
            ABAR();
            { unsigned any = 0u;
#pragma unroll
              for (int w = 0; w < 8; ++w) any |= fl[par * 8 + w];
              par ^= 1;
              if (ka < 0 || any == 0u) break; }
            const int kc = kb - 1;
            gload(kc, sA);
            if (!done) compute(ka, cur ^ 1);
            step_done(ka);
            if (lane == 0) fl[par * 8 + wave] = done ? 0u : 1u;
            lstore(cur, sB);
            ABAR();
            { unsigned any = 0u;
#pragma unroll
              for (int w = 0; w < 8; ++w) any |= fl[par * 8 + w];
              par ^= 1;
              if (kb < 0 || any == 0u) break; }
            kt = kb; ka = kc;
        }
    } else {
        int kt = nxt(-1), cur = 0;
        gload(kt, sA); lstore(0, sA);
        int ka = nxt(kt);
        gload(ka, sA);
        asm volatile("" : "+v"(qf[0]), "+v"(qf[1]), "+v"(qf[2]), "+v"(qf[3]), "+v"(cql));
        ABAR();
        for (;;) {
            const int kb = nxt(ka);
            gload(kb, sB);
            compute(kt, cur);
            lstore(cur ^ 1, sA);
            ABAR();
            if (ka > wg_last) break;
            const int kc = nxt(kb);
            gload(kc, sA);
            compute(ka, cur ^ 1);
            lstore(cur, sB);
            ABAR();
            if (kb > wg_last) break;
            kt = kb; ka = kc;
        }
    }
    l_out = xsum32(l_run);
}

struct AttnArgs { const bf16_t* qkv; bf16_t* oa; bf16_t* ob; bf16_t* oc; const float* cum; const float* kmean; const float* gsub; float lam, lam_init; unsigned* ctl; const unsigned* kmax; };
DI void phase_attn(const AttnArgs& a, unsigned char* lds, int wave_s) {
    const int tid = opaque_tid(wave_s), lane0 = tid & 63, wave = tid >> 6;
    volatile unsigned* bc = (volatile unsigned*)(lds + LDS_MISC);
    unsigned* stash = (unsigned*)(lds + wave * 8192);
    for (;;) {
        if (tid == 0) bc[0] = atomicAdd(a.ctl, 1u);
        __syncthreads();
        const unsigned u = bc[0];
        __syncthreads();
        if (u >= 1536u) break;
        int lane = lane0; asm volatile("" : "+v"(lane));
        const int r = lane & 31, h = lane >> 5;
        if (u < 512u) {
            const int qb = 7 - (int)(u >> 6), bh = (int)(u & 63u), b = bh >> 2, head = bh & 3;
            const int q0 = qb * 256 + wave * 32;
            const bf16_t* Vt = a.qkv + VA_OFF + (size_t)bh * SEQ * 128;
#pragma unroll 1
            for (int half = 0; half < 2; ++half) {
                f32x16 O[4]; float l;
                attn_stream<4, 0>(a.qkv + QA_OFF + (size_t)(b * 8 + 2 * head + half) * SEQ * 64, a.qkv + KA_OFF + (size_t)(b * 8 + 2 * head + half) * SEQ * 64, Vt, qb, wave, lane, tid, lds, O, l, nullptr, nullptr, 0.f);
                if (half == 0) {
                    const float inv = 1.f / l;
#pragma unroll
                    for (int dt = 0; dt < 4; ++dt) {
#pragma unroll
                        for (int i = 0; i < 16; i += 2) stash[(dt * 8 + (i >> 1)) * 64 + lane] = pk2(O[dt][i] * inv, O[dt][i + 1] * inv);
                        asm volatile("" ::: "memory"); }
                } else {
                    const float inv = a.lam / l; float ss = 0.f;
#pragma unroll
                    for (int dt = 0; dt < 4; ++dt) {
#pragma unroll
                        for (int i = 0; i < 16; i += 2) { const unsigned w = stash[(dt * 8 + (i >> 1)) * 64 + lane]; const float o0 = bflo(w) - O[dt][i] * inv, o1 = bfhi(w) - O[dt][i + 1] * inv; O[dt][i] = o0; O[dt][i + 1] = o1; ss += o0 * o0 + o1 * o1; }
                        asm volatile("" ::: "memory"); }
                    ss += shx(ss, 32, lane);
                    const float rstd = rsqrtf(ss * (1.f / 128.f) + RMS_EPS) * (1.f - a.lam_init);
                    bf16_t* op = a.oa + (size_t)(b * SEQ + q0 + r) * DM + head * 128;
#pragma unroll
                    for (int dt = 0; dt < 4; ++dt) {
#pragma unroll
                        for (int g = 0; g < 4; ++g) { const int d = dt * 32 + 8 * g + 4 * h; const f32x4 gs = *(const f32x4*)(a.gsub + d);
                            u32x2 w; w.x = pk2(O[dt][4 * g] * rstd * gs.x, O[dt][4 * g + 1] * rstd * gs.y); w.y = pk2(O[dt][4 * g + 2] * rstd * gs.z, O[dt][4 * g + 3] * rstd * gs.w);
                            *(u32x2*)(op + d) = w; }
                        asm volatile("" ::: "memory"); }
                }
            }
        } else {
            const unsigned v = u - 512u; const int qb = 7 - (int)(v >> 7), w7 = (int)(v & 127u), typ = 1 + (w7 >> 6), bh = w7 & 63, b = bh >> 2, head = bh & 3;
            const int q0 = qb * 256 + wave * 32;
            f32x16 O[2]; float l;
            bf16_t* op;
            if (typ == 1) {
                attn_stream<2, 1>(a.qkv + QB_OFF + (size_t)bh * SEQ * 64, a.qkv + KB_OFF + (size_t)bh * SEQ * 64, a.qkv + VB_OFF + (size_t)bh * SEQ * 64, qb, wave, lane, tid, lds, O, l, a.cum + (size_t)bh * SEQ, nullptr, __uint_as_float(a.kmax[bh]));
                op = a.oa + (size_t)(b * SEQ + q0 + r) * DM + 512 + head * 64;
            } else {
                attn_stream<2, 2>(a.qkv + QC_OFF + (size_t)bh * SEQ * 64, a.qkv + KC_OFF + (size_t)bh * SEQ * 64, a.qkv + VC_OFF + (size_t)bh * SEQ * 64, qb, wave, lane, tid, lds, O, l, nullptr, a.kmean + (size_t)bh * 8 * 64, 0.f);
                op = a.oa + (size_t)(b * SEQ + q0 + r) * DM + 768 + head * 64;
            }
            const float inv = 1.f / l;
#pragma unroll
            for (int dt = 0; dt < 2; ++dt)
#pragma unroll
                for (int g = 0; g < 4; ++g) { const int d = dt * 32 + 8 * g + 4 * h;
                    u32x2 w; w.x = pk2(O[dt][4 * g] * inv, O[dt][4 * g + 1] * inv); w.y = pk2(O[dt][4 * g + 2] * inv, O[dt][4 * g + 3] * inv);
                    *(u32x2*)(op + d) = w; }
        }
    }
}

#define XB_TMO      128
#define XB_XCNT(j)  (256  + 64 * (j))
#define XB_XSUB(j)  (1280 + 64 * (j))
#define XB_XGEN(j)  (2304 + 64 * (j))
#define XB_TOP      3328
#define XB_TOPGEN   3392
#define XCD_BAR_WORDS 3456
#define XB_SPIN_CAP (1u << 18)

__device__ __forceinline__ unsigned xb_ld(unsigned* p)              { return __hip_atomic_load(p, __ATOMIC_RELAXED, __HIP_MEMORY_SCOPE_AGENT); }
__device__ __forceinline__ unsigned xb_add(unsigned* p, unsigned v) { return __hip_atomic_fetch_add(p, v, __ATOMIC_RELAXED, __HIP_MEMORY_SCOPE_AGENT); }
__device__ __forceinline__ unsigned xb_xcc_id() { return (unsigned)__builtin_amdgcn_s_getreg((3 << 11) | 20) & 0xFu; }
#define XB_SPIN(cond, bar) do { unsigned _sp = 0; while (cond) { __builtin_amdgcn_s_sleep(1); \
    if ((++_sp & 255u) == 0u) { if (xb_ld(&(bar)[XB_TMO])) break; if (_sp > XB_SPIN_CAP) { atomicAdd(&(bar)[XB_TMO], 1u); break; } } } } while (0)

struct XcdBarrier {
    unsigned* bar; unsigned x;
    volatile LAS unsigned* st;
};

__device__ __forceinline__ XcdBarrier xcd_barrier_post(unsigned* bar, volatile LAS unsigned* st, int tid) {
    XcdBarrier b; b.bar = bar; b.x = xb_xcc_id(); b.st = st;
    if (tid == 0) (void)xb_add(&bar[XB_XCNT(b.x)], 1u);
    return b;
}
__device__ __forceinline__ void xcd_barrier_complete(unsigned* bar, unsigned x, unsigned& nloc, unsigned& nx) {
    const unsigned G = gridDim.x * gridDim.y * gridDim.z;
    unsigned sum, cnt, mine, sp = 0u;
    for (;;) {
        sum = 0u; cnt = 0u; mine = 0u;
#pragma unroll
        for (unsigned j = 0; j < 16; ++j) { const unsigned c = xb_ld(&bar[XB_XCNT(j)]); sum += c; cnt += (c > 0u) ? 1u : 0u; mine = (j == x) ? c : mine; }
        if (sum == G) break;
        __builtin_amdgcn_s_sleep(1);
        if ((++sp & 255u) == 0u) { if (xb_ld(&bar[XB_TMO])) break; if (sp > XB_SPIN_CAP) { atomicAdd(&bar[XB_TMO], 1u); break; } }
    }
    nloc = mine > 0u ? mine : 1u; nx = cnt > 0u ? cnt : 1u;
}

__device__ __forceinline__ void xcd_barrier(const XcdBarrier& b, int tid) {
    asm volatile("s_waitcnt vmcnt(0)" ::: "memory");
    __syncthreads();
    if (tid == 0) {
        unsigned* bar = b.bar;
        __builtin_amdgcn_s_waitcnt(0);
        unsigned nloc = b.st[0], nx = b.st[1];
        if (nloc == 0u) { xcd_barrier_complete(bar, b.x, nloc, nx); b.st[0] = nloc; b.st[1] = nx; }
        const unsigned old = xb_add(&bar[XB_XSUB(b.x)], 1u);
        const unsigned gen = old / nloc;
        if (old + 1u == (gen + 1u) * nloc) {
            __builtin_amdgcn_fence(__ATOMIC_RELEASE, "agent");
            asm volatile("s_waitcnt vmcnt(0)" ::: "memory");
            const unsigned og = xb_add(&bar[XB_TOP], 1u);
            const unsigned tg = og / nx;
            if (og + 1u == (tg + 1u) * nx) xb_add(&bar[XB_TOPGEN], 1u);
            else XB_SPIN(xb_ld(&bar[XB_TOPGEN]) == tg, bar);
            __builtin_amdgcn_fence(__ATOMIC_ACQUIRE, "agent");
            xb_add(&bar[XB_XGEN(b.x)], 1u);
            asm volatile("s_waitcnt vmcnt(0)" ::: "memory");
        } else {
            XB_SPIN(xb_ld(&bar[XB_XGEN(b.x)]) == gen, bar);
            __builtin_amdgcn_fence(__ATOMIC_ACQUIRE, "agent");
            asm volatile("s_waitcnt vmcnt(0)" ::: "memory");
        }
    }
    __syncthreads();
}

typedef const Params __attribute__((address_space(4))) CParams;
DI CParams* fresh_params() { CParams* kp = (CParams*)__builtin_amdgcn_kernarg_segment_ptr(); asm volatile("" : "+s"(kp)); return kp; }
#define PHASE_BEGIN CParams* kp = fresh_params(); unsigned char* ws = kp->ws; (void)ws;
#define PIN(i) (kp->in[i])
#define MODP ((float*)(ws + WS_MOD))
#ifdef PROBE_CLASS
#define PLDS ((volatile unsigned long long*)(lds + LDS_MISC + 64))
#define PROBE_T0() do { if (blockIdx.x == 0 && opaque_tid(wave_s) == 0) PLDS[0] = __builtin_amdgcn_s_memrealtime(); } while (0)
#define PROBE_T1(cls) do { if ((cls) == PROBE_CLASS && blockIdx.x == 0 && opaque_tid(wave_s) == 0) PLDS[1] += __builtin_amdgcn_s_memrealtime() - PLDS[0]; } while (0)
#else
#define PROBE_T0() do { } while (0)
#define PROBE_T1(cls) do { } while (0)
#endif
__global__ void __launch_bounds__(512, 2) fwd_megakernel(Params p) {
    extern __shared__ __attribute__((aligned(16))) unsigned char lds[];
    cg::grid_group grid = cg::this_grid();
    const int wave_s = __builtin_amdgcn_readfirstlane((int)(threadIdx.x >> 6));
    {
        volatile LAS unsigned* st = (volatile LAS unsigned*)(lds + LDS_MISC + 256);
        if (opaque_tid(wave_s) == 0) { st[0] = 0u; st[1] = 0u; }
        __syncthreads();
    }
    (void)xcd_barrier_post((unsigned*)(fresh_params()->ws + WS_BAR), (volatile LAS unsigned*)(lds + LDS_MISC + 256), opaque_tid(wave_s));
#define GSYNC() do { XcdBarrier xb_; xb_.bar = (unsigned*)(fresh_params()->ws + WS_BAR); xb_.x = xb_xcc_id(); xb_.st = (volatile LAS unsigned*)(lds + LDS_MISC + 256); xcd_barrier(xb_, opaque_tid(wave_s)); } while (0)
#ifdef PROBE_CLASS
    if (blockIdx.x == 0 && opaque_tid(wave_s) == 0) PLDS[1] = 0ull;
#endif
    PROBE_T0();
    {
        PHASE_BEGIN
#ifndef NO_P0
        phase_mod((const float*)PIN(1), (const float*)PIN(3), (const float*)PIN(4), MODP, lds, wave_s);
        __syncthreads();
        phase_conv(kp, 0, lds, wave_s);
#endif
    }
    if (gridDim.x == 0x7fffffffu) grid.sync();
    GSYNC();
    PROBE_T1(0); PROBE_T0();
#ifdef EXP_SYNC
    for (int i = 0; i < 20; ++i) { GSYNC(); }
    PROBE_T1(9); PROBE_T0();
#endif
    {
        PHASE_BEGIN
        RowArgs a{};
        a.xsrc = (const float*)PIN(0); a.y = nullptr; a.gpost = nullptr; a.gt = nullptr; a.y2 = nullptr; a.gpost2 = nullptr; a.gt2 = nullptr; a.xdst = nullptr;
        a.gpre = (const float*)PIN(5); a.sc = MODP + 1 * DM; a.sh = MODP + 0 * DM; a.hdst = (bf16_t*)(ws + WS_H);
        a.wfgt = (const float*)PIN(7) + 6144; a.bfgt = (const float*)PIN(8); a.logf = (float*)(ws + WS_LOGF);
        phase_rows(a, lds, wave_s);
    }
    GSYNC();
    PROBE_T1(1); PROBE_T0();
#pragma unroll 1
    for (int l = 0; l < 2; ++l) {
        {
            PHASE_BEGIN
            pg8::Gemm g{(const bf16_t*)(ws + WS_H), (const bf16_t*)(ws + WS_WIN), MT, NQG, DM}; pg8::StaticOrder S; S.init(MT, NQG, (int)gridDim.x, (int)blockIdx.x);
            EpiIn E{(bf16_t*)(ws + WS_QKV), (bf16_t*)(ws + WS_GATE), (const int*)PIN(2)};
            pg8::gemm_phase<EpiIn, pg8::StaticOrder, true, true>((PG8_LAS unsigned char*)lds, g, S, E, opaque_tid(wave_s));
        }
        GSYNC();
        PROBE_T1(2); PROBE_T0();
        {
            PHASE_BEGIN
            phase_mini((const float*)(ws + WS_LOGF), (float*)(ws + WS_CUM), (const bf16_t*)(ws + WS_QKV) + KC_OFF, (float*)(ws + WS_KMEAN), (unsigned*)(ws + WS_CTL), (const bf16_t*)(ws + WS_QKV) + KB_OFF, (unsigned*)(ws + WS_CTL + 2048) + l * 64, wave_s);
        }
        GSYNC();
        PROBE_T1(3); PROBE_T0();
        {
            PHASE_BEGIN
            const int lane = opaque_tid(wave_s) & 63;
            const float lam_init = (l == 0) ? 0.2f : 0.35550906759f;
            const float q1 = ((const float*)PIN(9))[l * 64 + lane], k1 = ((const float*)PIN(10))[l * 64 + lane];
            const float q2 = ((const float*)PIN(11))[l * 64 + lane], k2 = ((const float*)PIN(12))[l * 64 + lane];
            const float lam = __expf(wave_sum(q1 * k1, lane)) - __expf(wave_sum(q2 * k2, lane)) + lam_init;
            AttnArgs a{(const bf16_t*)(ws + WS_QKV), (bf16_t*)(ws + WS_OA), (bf16_t*)(ws + WS_OB), (bf16_t*)(ws + WS_OC), (const float*)(ws + WS_CUM), (const float*)(ws + WS_KMEAN),
                       (const float*)PIN(13) + l * 128, lam, lam_init, (unsigned*)(ws + WS_CTL), (const unsigned*)(ws + WS_CTL + 2048) + l * 64};
#ifndef NO_ATTN
            phase_attn(a, lds, wave_s);
#endif
        }
        GSYNC();
        PROBE_T1(4); PROBE_T0();
        {
            PHASE_BEGIN
            pg8::StaticOrder S; S.init(MT, DM, (int)gridDim.x, (int)blockIdx.x);
            pg8::Gemm g{(const bf16_t*)(ws + WS_OA), (const bf16_t*)(ws + WS_WBA), MT, DM, DM}; EpiMergeK E{(const bf16_t*)(ws + WS_GATE), (bf16_t*)(ws + WS_MERGED)};
            pg8::gemm_phase<EpiMergeK, pg8::StaticOrder, true, true>((PG8_LAS unsigned char*)lds, g, S, E, opaque_tid(wave_s));
        }
        GSYNC();
        PROBE_T1(5); PROBE_T0();
        {
            PHASE_BEGIN
            pg8::Gemm g{(const bf16_t*)(ws + WS_MERGED), (const bf16_t*)(ws + WS_WOUT), MT, DM, DM}; pg8::StaticOrder S; S.init(MT, DM, (int)gridDim.x, (int)blockIdx.x);
            EpiPlain E{(bf16_t*)(ws + WS_Y), DM};
            pg8::gemm_phase<EpiPlain, pg8::StaticOrder, true, true>((PG8_LAS unsigned char*)lds, g, S, E, opaque_tid(wave_s));
        }
        GSYNC();
        PROBE_T1(6); PROBE_T0();
        {
            PHASE_BEGIN
            const float* modl = MODP + (size_t)l * 16 * 6144;
            RowArgs a{};
            a.xsrc = (l == 0) ? (const float*)PIN(0) : (const float*)kp->out; a.y = (const bf16_t*)(ws + WS_Y); a.gpost = (const float*)PIN(6) + l * DM; a.gt = modl + 2 * DM; a.xdst = nullptr;
            a.y2 = nullptr; a.gpost2 = nullptr; a.gt2 = nullptr;
            a.gpre = (const float*)PIN(18) + l * DM; a.sc = modl + 4 * DM; a.sh = modl + 3 * DM; a.hdst = (bf16_t*)(ws + WS_H);
            a.wfgt = nullptr; a.bfgt = nullptr; a.logf = nullptr;
            phase_rows(a, lds, wave_s);
        }
        GSYNC();
        PROBE_T1(1); PROBE_T0();
        {
            PHASE_BEGIN
            pg8::Gemm g{(const bf16_t*)(ws + WS_H), (const bf16_t*)(ws + WS_WGU), MT, NGU, DM}; pg8::StaticOrder S; S.init(MT, NGU, (int)gridDim.x, (int)blockIdx.x);
            EpiSwiglu E{(bf16_t*)(ws + WS_ACT)};
            pg8::gemm_phase<EpiSwiglu, pg8::StaticOrder, true, true>((PG8_LAS unsigned char*)lds, g, S, E, opaque_tid(wave_s));
        }
        GSYNC();
        PROBE_T1(7); PROBE_T0();
        {
            PHASE_BEGIN
            pg8::Gemm g{(const bf16_t*)(ws + WS_ACT), (const bf16_t*)(ws + WS_WDN), MT, DM, DFF}; pg8::StaticOrder S; S.init(MT, DM, (int)gridDim.x, (int)blockIdx.x);
            EpiPlain E{(bf16_t*)(ws + WS_DN), DM};
            pg8::gemm_phase<EpiPlain, pg8::StaticOrder, true, true>((PG8_LAS unsigned char*)lds, g, S, E, opaque_tid(wave_s));
        }
        GSYNC();
        PROBE_T1(8); PROBE_T0();
        {
            PHASE_BEGIN
            const float* modl = MODP + (size_t)l * 16 * 6144;
            RowArgs a{};
            a.xsrc = (l == 0) ? (const float*)PIN(0) : (const float*)kp->out; a.y = (const bf16_t*)(ws + WS_Y); a.gpost = (const float*)PIN(6) + l * DM; a.gt = modl + 2 * DM;
            a.y2 = (const bf16_t*)(ws + WS_DN); a.gpost2 = (const float*)PIN(19) + l * DM; a.gt2 = modl + 5 * DM; a.xdst = kp->out;
            if (l == 0) {
                const float* mod1 = MODP + (size_t)16 * 6144;
                a.gpre = (const float*)PIN(5) + DM; a.sc = mod1 + 1 * DM; a.sh = mod1 + 0 * DM; a.hdst = (bf16_t*)(ws + WS_H);
                a.wfgt = (const float*)PIN(7) + (size_t)DM * DIN + 6144; a.bfgt = (const float*)PIN(8) + 4; a.logf = (float*)(ws + WS_LOGF);
            } else { a.gpre = nullptr; a.sc = nullptr; a.sh = nullptr; a.hdst = nullptr; a.wfgt = nullptr; a.bfgt = nullptr; a.logf = nullptr; }
#ifdef PROBE_CLASS
            if (l == 1) {
                if (blockIdx.x == 0 && opaque_tid(wave_s) == 0) *(volatile unsigned long long*)(ws + WS_CTL + 512) = PLDS[1];
                GSYNC();
                const unsigned long long ticks = *(volatile unsigned long long*)(ws + WS_CTL + 512);
                a.probe_eps = sqrtf((float)ticks * 0.01f * 4.8e-7f);
            }
#endif
            phase_rows(a, lds, wave_s);
            if (l == 0) {
                __syncthreads();
#ifndef NO_P0
                phase_conv(kp, 1, lds, wave_s);
#endif
            }
        }
        if (l == 0) { GSYNC(); PROBE_T1(1); PROBE_T0(); }
    }
}

extern "C" void kernel_launch(void* const* d_in, const int* in_sizes, int n_in, void* d_out, int out_size, void* d_ws, size_t ws_size, hipStream_t stream) {
    static int grid = 0;
    if (grid == 0) {
        if (n_in != 22 || out_size != MT * DM || ws_size < WS_END) { fprintf(stderr, "kernel_launch: unexpected problem (n_in %d, out %d, ws %zu)\n", n_in, out_size, ws_size); grid = -1; return; }
        int dev = 0, cus = 0, per_cu = 0;
        if (hipGetDevice(&dev) != hipSuccess || hipDeviceGetAttribute(&cus, hipDeviceAttributeMultiprocessorCount, dev) != hipSuccess) { grid = -1; return; }
        if (hipFuncSetAttribute((const void*)fwd_megakernel, hipFuncAttributeMaxDynamicSharedMemorySize, LDS_BYTES) != hipSuccess) { fprintf(stderr, "kernel_launch: hipFuncSetAttribute failed\n"); grid = -1; return; }
        if (hipOccupancyMaxActiveBlocksPerMultiprocessor(&per_cu, (const void*)fwd_megakernel, 512, LDS_BYTES) != hipSuccess || per_cu < 1) { fprintf(stderr, "kernel_launch: occupancy query says %d\n", per_cu); per_cu = 1; }
        (void)hipGetLastError();
        grid = cus * 1;
    }
    if (grid < 0) return;
    if (hipMemsetAsync((char*)d_ws + WS_CTL, 0, 65536, stream) != hipSuccess) { fprintf(stderr, "kernel_launch: memset failed\n"); return; }
    Params p{};
    for (int i = 0; i < 22; ++i) p.in[i] = d_in[i];
    p.out = (float*)d_out; p.ws = (unsigned char*)d_ws;
    void* args[] = {&p};
    const hipError_t e = hipLaunchCooperativeKernel((const void*)fwd_megakernel, dim3(grid), dim3(512), args, LDS_BYTES, stream);
    if (e != hipSuccess) fprintf(stderr, "kernel_launch: cooperative launch failed: %s (grid %d)\n", hipGetErrorString(e), grid);
}
```
